# Optimizing an MI355X kernel written in HIP

```python
import jax, jax.numpy as jnp
from jax import lax
import numpy as np

D_MODEL = 1024
BATCH = 32
SEQ = 256
DEPTH = 4
DEC_BATCH = 4
DEC_SEQ = 4096
PAST_LEN = 512

GRID_W = 64
BLOCK = 128
WINDOW = 128
HEAD_DIM = 64
A_HEADS = 8
A_KV = 2
B_HEADS = 8
B_Q_LORA = 384
B_KV_LORA = 256
B_NOPE = 64
B_ROPE = 32
B_V = 64
C_HEADS = 8
C_KV = 2
D_FF = 4 * D_MODEL
N_BRANCH = 3
N_MOD = 6
ROPE_THETA = 10000.0
EPS = 1e-6
NEG = -1e30

IN_SIZES = (A_HEADS * HEAD_DIM, A_KV * HEAD_DIM, A_KV * HEAD_DIM,
            B_Q_LORA, B_KV_LORA, B_ROPE,
            C_HEADS * HEAD_DIM, C_KV * HEAD_DIM, C_KV * HEAD_DIM,
            N_BRANCH * D_MODEL)
IN_SPLITS = tuple(int(s) for s in np.cumsum(IN_SIZES)[:-1])
IN_COLS = int(sum(IN_SIZES))

kernel_name = 'hybrid_diffusion_step'


def _rmsnorm(x, g):
    xf = x.astype(jnp.float32)
    y = xf * lax.rsqrt(jnp.mean(xf * xf, axis=-1, keepdims=True) + EPS)
    return (y * g.astype(jnp.float32)).astype(x.dtype)


def _rope_1d(x, pos):
    half = x.shape[-1] // 2
    inv = ROPE_THETA ** (-jnp.arange(half, dtype=jnp.float32) / half)
    ang = pos.astype(jnp.float32)[:, None] * inv[None, :]
    cos = jnp.cos(ang)[:, None, :].astype(x.dtype)
    sin = jnp.sin(ang)[:, None, :].astype(x.dtype)
    x1, x2 = x[..., :half], x[..., half:]
    return jnp.concatenate([x1 * cos - x2 * sin, x2 * cos + x1 * sin], axis=-1)


def _axial_rope(x):
    n = x.shape[1]
    rows = n // GRID_W
    row = jnp.repeat(jnp.arange(rows, dtype=jnp.int32), GRID_W)
    col = jnp.tile(jnp.arange(GRID_W, dtype=jnp.int32), rows)
    half = x.shape[-1] // 2
    return jnp.concatenate([_rope_1d(x[..., :half], row), _rope_1d(x[..., half:], col)], axis=-1)


def _attend_block(qb, ks, vs, masks, sink, scale):
    bsz, nq, nh, dk = qb.shape
    ng = ks[0].shape[2]
    nr = nh // ng
    qg = qb.reshape(bsz, nq, ng, nr, dk)
    logits = []
    for k, m in zip(ks, masks):
        s = jnp.einsum('bqgrd,bkgd->bgrqk', qg, k).astype(jnp.float32) * scale
        if m is not None:
            s = jnp.where(m, s, NEG)
        logits.append(s)
    if sink is not None:
        logits.append(jnp.broadcast_to(sink.astype(jnp.float32).reshape(1, ng, nr, 1, 1), (bsz, ng, nr, nq, 1)))
    probs = jax.nn.softmax(jnp.concatenate(logits, axis=-1), axis=-1)
    out = None
    off = 0
    for v in vs:
        n = v.shape[1]
        term = jnp.einsum('bgrqk,bkgd->bqgrd', probs[..., off:off + n].astype(v.dtype), v)
        out = term if out is None else out + term
        off += n
    return out.reshape(bsz, nq, nh, vs[0].shape[-1])


def _sweep(q, k_ctx, v_ctx, sink, k_lat=None, v_lat=None, window=None):
    bsz, n, nh, dk = q.shape
    nb = n // BLOCK
    scale = dk ** -0.5
    qb = q.reshape(bsz, nb, BLOCK, nh, dk).swapaxes(0, 1)
    if k_lat is None:
        def body(args):
            _, qi = args
            return _attend_block(qi, [k_ctx], [v_ctx], [None], sink, scale)
    elif window is None:
        def body(args):
            _, qi = args
            return _attend_block(qi, [k_lat, k_ctx], [v_lat, v_ctx], [None, None], sink, scale)
    else:
        pad = [(0, 0), (BLOCK, BLOCK), (0, 0), (0, 0)]
        kp = jnp.pad(k_lat, pad)
        vp = jnp.pad(v_lat, pad)

        def body(args):
            b, qi = args
            start = b * BLOCK
            kw = lax.dynamic_slice_in_dim(kp, start, 3 * BLOCK, axis=1)
            vw = lax.dynamic_slice_in_dim(vp, start, 3 * BLOCK, axis=1)
            qpos = start + jnp.arange(BLOCK)
            kpos = start - BLOCK + jnp.arange(3 * BLOCK)
            mask = ((jnp.abs(qpos[:, None] - kpos[None, :]) <= window)
                    & (kpos >= 0)[None, :] & (kpos < n)[None, :])
            return _attend_block(qi, [kw, k_ctx], [vw, v_ctx], [mask, None], sink, scale)
    out = lax.map(body, (jnp.arange(nb, dtype=jnp.int32), qb))
    return out.swapaxes(0, 1).reshape(bsz, n, nh, out.shape[-1])


def _project(h, p):
    bsz, n, _ = h.shape
    z = h @ p['w_in']
    qa, ka, va, qbd, kvbd, kbr, qc, kc, vc, gates = jnp.split(z, IN_SPLITS, axis=-1)
    qa = qa.reshape(bsz, n, A_HEADS, HEAD_DIM)
    ka = ka.reshape(bsz, n, A_KV, HEAD_DIM)
    va = va.reshape(bsz, n, A_KV, HEAD_DIM)
    qb = (_rmsnorm(qbd, p['g_qa']) @ p['w_qup']).reshape(bsz, n, B_HEADS, B_NOPE + B_ROPE)
    ckv = _rmsnorm(kvbd, p['g_kva'])
    qc = _rmsnorm(qc.reshape(bsz, n, C_HEADS, HEAD_DIM), p['g_qc'])
    kc = _rmsnorm(kc.reshape(bsz, n, C_KV, HEAD_DIM), p['g_kc'])
    vc = vc.reshape(bsz, n, C_KV, HEAD_DIM)
    return qa, ka, va, qb, ckv, kbr, qc, kc, vc, gates


def _mla_expand(ckv, kbr, w_kvup):
    bsz, n, _ = ckv.shape
    kv = (ckv @ w_kvup).reshape(bsz, n, B_HEADS, B_NOPE + B_V)
    k_nope, v = kv[..., :B_NOPE], kv[..., B_NOPE:]
    k_rope = jnp.broadcast_to(kbr[:, :, None, :], (bsz, n, B_HEADS, B_ROPE))
    return jnp.concatenate([k_nope, k_rope], axis=-1), v


def _merge(gates, oa, ob, oc, p):
    bsz, n = oa.shape[:2]
    ga, gb, gc = jnp.split(jax.nn.sigmoid(gates), N_BRANCH, axis=-1)
    m = (ga * (oa.reshape(bsz, n, -1) @ p['w_oa'])
         + gb * (ob.reshape(bsz, n, -1) @ p['w_ob'])
         + gc * (oc.reshape(bsz, n, -1) @ p['w_oc']))
    return m @ p['w_out']


def _mix_context(h, p):
    qa, ka, va, qb, ckv, kbr, qc, kc, vc, gates = _project(h, p)
    kb, vb = _mla_expand(ckv, kbr, p['w_kvup'])
    oa = _sweep(qa, ka, va, p['a_sink'])
    ob = _sweep(qb, kb, vb, None)
    oc = _sweep(qc, kc, vc, None)
    return _merge(gates, oa, ob, oc, p), (ka, va, ckv, kbr, kc, vc)


def _mix_latent(h, p, ctx):
    ka_c, va_c, ckv_c, kbr_c, kc_c, vc_c = ctx
    qa, ka, va, qb, ckv, kbr, qc, kc, vc, gates = _project(h, p)
    qa = _axial_rope(qa)
    ka = _axial_rope(ka)
    qb = jnp.concatenate([qb[..., :B_NOPE], _axial_rope(qb[..., B_NOPE:])], axis=-1)
    kbr = _axial_rope(kbr[:, :, None, :])[:, :, 0, :]
    qc = _axial_rope(qc)
    kc = _axial_rope(kc)
    kb, vb = _mla_expand(ckv, kbr, p['w_kvup'])
    kb_c, vb_c = _mla_expand(ckv_c, kbr_c, p['w_kvup'])
    oa = _sweep(qa, ka_c, va_c, p['a_sink'], ka, va, WINDOW)
    ob = _sweep(qb, kb_c, vb_c, None, kb, vb)
    oc = _sweep(qc, kc_c, vc_c, None, kc, vc)
    return _merge(gates, oa, ob, oc, p), None


def _sandwich_layer(x, mod, p, mix_fn):
    sh1, sc1, g1, sh2, sc2, g2 = jnp.split(mod, N_MOD, axis=-1)
    h = _rmsnorm(x, p['g_pre_mix']) * (1 + sc1) + sh1
    mixed, aux = mix_fn(h)
    x = x + g1 * _rmsnorm(mixed, p['g_post_mix'])
    h = _rmsnorm(x, p['g_pre_mlp']) * (1 + sc2) + sh2
    f = jnp.square(jax.nn.relu(h @ p['w_mlp1'])) @ p['w_mlp2']
    x = x + g2 * _rmsnorm(f, p['g_post_mlp'])
    return x, aux


def setup_inputs(seed: int = 0) -> dict:
    key = jax.random.key(seed)
    ks = jax.random.split(key, 32)

    def nrm(k, shape, scale=1.0):
        return jax.random.normal(k, shape, jnp.float32) * scale

    def gain(k, shape):
        return 1.0 + 0.1 * jax.random.normal(k, shape, jnp.float32)

    return {
        'x_prompt': nrm(ks[0], (BATCH, SEQ, D_MODEL)),
        'x_sample': nrm(ks[1], (DEC_BATCH, DEC_SEQ, D_MODEL)),
        'cache_a_k': nrm(ks[2], (DEC_BATCH, DEPTH, PAST_LEN, A_KV, HEAD_DIM)),
        'cache_a_v': nrm(ks[3], (DEC_BATCH, DEPTH, PAST_LEN, A_KV, HEAD_DIM)),
        'cache_b_ckv': nrm(ks[4], (DEC_BATCH, DEPTH, PAST_LEN, B_KV_LORA)),
        'cache_b_krope': nrm(ks[5], (DEC_BATCH, DEPTH, PAST_LEN, B_ROPE)),
        'cache_c_k': nrm(ks[6], (DEC_BATCH, DEPTH, PAST_LEN, C_KV, HEAD_DIM)),
        'cache_c_v': nrm(ks[7], (DEC_BATCH, DEPTH, PAST_LEN, C_KV, HEAD_DIM)),
        'c': nrm(ks[8], (DEC_BATCH, D_MODEL)),
        'c_ctx': nrm(ks[9], (D_MODEL,)),
        'w_mod': nrm(ks[10], (DEPTH, D_MODEL, N_MOD * D_MODEL), 0.5 * D_MODEL ** -0.5),
        'b_mod': nrm(ks[11], (DEPTH, N_MOD * D_MODEL), 0.01),
        'g_pre_mix': gain(ks[12], (DEPTH, D_MODEL)),
        'g_post_mix': gain(ks[13], (DEPTH, D_MODEL)),
        'g_pre_mlp': gain(ks[14], (DEPTH, D_MODEL)),
        'g_post_mlp': gain(ks[15], (DEPTH, D_MODEL)),
        'w_in': nrm(ks[16], (DEPTH, D_MODEL, IN_COLS), D_MODEL ** -0.5),
        'a_sink': nrm(ks[17], (DEPTH, A_HEADS), 0.5),
        'g_qa': gain(ks[18], (DEPTH, B_Q_LORA)),
        'w_qup': nrm(ks[19], (DEPTH, B_Q_LORA, B_HEADS * (B_NOPE + B_ROPE)), B_Q_LORA ** -0.5),
        'g_kva': gain(ks[20], (DEPTH, B_KV_LORA)),
        'w_kvup': nrm(ks[21], (DEPTH, B_KV_LORA, B_HEADS * (B_NOPE + B_V)), B_KV_LORA ** -0.5),
        'g_qc': gain(ks[22], (DEPTH, HEAD_DIM)),
        'g_kc': gain(ks[23], (DEPTH, HEAD_DIM)),
        'w_oa': nrm(ks[24], (DEPTH, A_HEADS * HEAD_DIM, D_MODEL), (A_HEADS * HEAD_DIM) ** -0.5),
        'w_ob': nrm(ks[25], (DEPTH, B_HEADS * B_V, D_MODEL), (B_HEADS * B_V) ** -0.5),
        'w_oc': nrm(ks[26], (DEPTH, C_HEADS * HEAD_DIM, D_MODEL), (C_HEADS * HEAD_DIM) ** -0.5),
        'w_out': nrm(ks[27], (DEPTH, D_MODEL, D_MODEL), D_MODEL ** -0.5),
        'w_mlp1': nrm(ks[28], (DEPTH, D_MODEL, D_FF), D_MODEL ** -0.5),
        'w_mlp2': nrm(ks[29], (DEPTH, D_FF, D_MODEL), D_FF ** -0.5),
    }


def reference(x_prompt, x_sample, cache_a_k, cache_a_v, cache_b_ckv, cache_b_krope, cache_c_k, cache_c_v,
              c, c_ctx, w_mod, b_mod, g_pre_mix, g_post_mix, g_pre_mlp, g_post_mlp, w_in, a_sink,
              g_qa, w_qup, g_kva, w_kvup, g_qc, g_kc, w_oa, w_ob, w_oc, w_out, w_mlp1, w_mlp2):
    def layer_params(l):
        return {'g_pre_mix': g_pre_mix[l], 'g_post_mix': g_post_mix[l],
                'g_pre_mlp': g_pre_mlp[l], 'g_post_mlp': g_post_mlp[l],
                'w_in': w_in[l], 'a_sink': a_sink[l], 'g_qa': g_qa[l], 'w_qup': w_qup[l],
                'g_kva': g_kva[l], 'w_kvup': w_kvup[l], 'g_qc': g_qc[l], 'g_kc': g_kc[l],
                'w_oa': w_oa[l], 'w_ob': w_ob[l], 'w_oc': w_oc[l], 'w_out': w_out[l],
                'w_mlp1': w_mlp1[l], 'w_mlp2': w_mlp2[l]}

    y_prompt = x_prompt
    ctx_list = []
    for l in range(DEPTH):
        p = layer_params(l)
        mod = jax.nn.silu(c_ctx) @ w_mod[l] + b_mod[l]
        y_prompt, ctx = _sandwich_layer(y_prompt, mod, p, lambda h: _mix_context(h, p))
        ctx_list.append(ctx)
    new_a_k = jnp.stack([t[0] for t in ctx_list], axis=1)
    new_a_v = jnp.stack([t[1] for t in ctx_list], axis=1)
    new_b_ckv = jnp.stack([t[2] for t in ctx_list], axis=1)
    new_b_krope = jnp.stack([t[3] for t in ctx_list], axis=1)
    new_c_k = jnp.stack([t[4] for t in ctx_list], axis=1)
    new_c_v = jnp.stack([t[5] for t in ctx_list], axis=1)

    y_sample = x_sample
    for l in range(DEPTH):
        p = layer_params(l)
        mod = (jax.nn.silu(c) @ w_mod[l] + b_mod[l])[:, None, :]
        ctx = (cache_a_k[:, l], cache_a_v[:, l], cache_b_ckv[:, l], cache_b_krope[:, l],
               cache_c_k[:, l], cache_c_v[:, l])
        y_sample, _ = _sandwich_layer(y_sample, mod, p, lambda h: _mix_latent(h, p, ctx))

    return (y_prompt, y_sample, new_a_k, new_a_v, new_b_ckv, new_b_krope, new_c_k, new_c_v)
```

```cpp
#include <hip/hip_runtime.h>
#include <hip/hip_cooperative_groups.h>
#include <stdint.h>
#include <stdio.h>
namespace cg = cooperative_groups;

#ifndef PROBE_VAR
#define PROBE_VAR 0
#endif
#ifndef PROBE_SUB
#define PROBE_SUB -1
#endif
#if PROBE_SUB >= 0
#define PROBE_FIRST (prep == 0)
#else
#define PROBE_FIRST true
#endif
#ifndef PROBE_DUP
#define PROBE_DUP 0
#endif
#ifndef MK_COOP
#define MK_COOP 1
#endif

typedef unsigned short u16;
typedef __attribute__((ext_vector_type(8))) short bf16x8;
typedef __attribute__((ext_vector_type(4))) float f32x4;
typedef __attribute__((ext_vector_type(16))) float f32x16;
typedef __attribute__((ext_vector_type(2))) float f32x2_t;
typedef __attribute__((ext_vector_type(2))) __bf16 bf16x2_t;

constexpr int DM = 1024, MCTX = 8192, MLAT = 16384, MT = 24576, DEPTH = 4;
constexpr int NIN = 5280, NINP = 5376;
constexpr float EPS = 1e-6f;
constexpr float LOG2E = 1.4426950408889634f;
constexpr float L2THETA = 13.287712379549449f;
constexpr float QSC_AC = 0.125f * 1.4426950408889634f, QSC_B = 0.10206207261596575f * 1.4426950408889634f;

constexpr size_t O_NAK = 25165824, O_NAV = 29360128, O_NCKV = 33554432, O_NKR = 41943040, O_NCK = 42991616, O_NCV = 47185920;

constexpr size_t MiB = 1u << 20;
constexpr size_t W_WIN = 0, W_WQ = 11 * MiB, W_WKV = 12 * MiB, W_WKVC = 12 * MiB + 512 * 1024, W_WO3 = 13 * MiB, W_WOUT = 16 * MiB,
                 W_W1 = 18 * MiB, W_W2 = 26 * MiB;
constexpr size_t W_KCA = 34 * MiB, W_VCAT = 34 * MiB + 512 * 1024, W_KCC = 35 * MiB, W_VCCT = 35 * MiB + 512 * 1024, W_CKVC = 36 * MiB,
                 W_KRC = 37 * MiB, W_KBNC = 38 * MiB, W_VBTC = 40 * MiB;
constexpr size_t W_MOD = 42 * MiB, W_SSQ = 43 * MiB, W_BAR = 43 * MiB + 900 * 1024, W_H = 44 * MiB;
constexpr size_t R1 = 92 * MiB;
constexpr size_t W_QA = R1, W_KA = R1 + 24 * MiB, W_VAT = R1 + 30 * MiB, W_QBD = R1 + 36 * MiB, W_KVBD = R1 + 54 * MiB, W_QB = R1 + 66 * MiB,
                 W_KBN = R1 + 102 * MiB, W_VBT = R1 + 126 * MiB, W_KR = R1 + 150 * MiB, W_QC = R1 + 152 * MiB, W_KC = R1 + 176 * MiB,
                 W_VCT = R1 + 182 * MiB, W_GATES = R1 + 188 * MiB, W_END = R1 + 332 * MiB;
constexpr size_t W_T = R1 + 200 * MiB;
constexpr size_t W_U = R1;
constexpr size_t W_MBUF = W_KBN;

struct Params { const float* in[30]; float* out; unsigned char* ws; };
enum { I_XP = 0, I_XS, I_CAK, I_CAV, I_CCKV, I_CKR, I_CCK, I_CCV, I_C, I_CCTX, I_WMOD, I_BMOD, I_GPREMIX, I_GPOSTMIX, I_GPREMLP, I_GPOSTMLP,
       I_WIN, I_SINK, I_GQA, I_WQUP, I_GKVA, I_WKVUP, I_GQC, I_GKC, I_WOA, I_WOB, I_WOC, I_WOUT, I_W1, I_W2 };

__device__ __forceinline__ unsigned pk2(float lo, float hi) { f32x2_t v = {lo, hi}; bf16x2_t b = __builtin_convertvector(v, bf16x2_t); return __builtin_bit_cast(unsigned, b); }
__device__ __forceinline__ float bflo(unsigned u) { return __uint_as_float(u << 16); }
__device__ __forceinline__ float bfhi(unsigned u) { return __uint_as_float(u & 0xffff0000u); }
__device__ __forceinline__ float wave_sum(float v) {
#pragma unroll
  for (int o = 32; o >= 1; o >>= 1) v += __shfl_xor(v, o);
  return v;
}
__device__ __forceinline__ int tidx() { int t = threadIdx.x; asm volatile("" : "+v"(t)); return t; }
__device__ __forceinline__ uint4 ld16(const void* p) { return *(const uint4*)p; }
__device__ __forceinline__ void st4bf(u16* p, f32x4 v) { uint2 w; w.x = pk2(v[0], v[1]); w.y = pk2(v[2], v[3]); *(uint2*)p = w; }

__device__ __forceinline__ size_t tiled_off(int r, int k, int K) { return (size_t)(r & ~15) * K + (size_t)(k >> 5) * 512 + (r & 15) * 32 + (k & 31); }
__device__ __forceinline__ int perm_col(int type, int n) {
  if (type == 1) { if (n < 1408) return n; if (n < 1440) return 5248 + (n - 1408); return n - 32; }
  if (type == 2) { int h = n / 96, d = n - h * 96; return d < 64 ? h * 64 + d : 512 + h * 32 + (d - 64); }
  if (type == 3) { int h = n >> 7, d = n & 127; return d < 64 ? h * 64 + d : 512 + h * 64 + (d - 64); }
  return n;
}
__device__ __forceinline__ void conv_tile(const float* __restrict__ src, int K, int N, u16* __restrict__ dst, int k0, int n0, int type,
                                          const float* __restrict__ scale, char* smem, bool tiled = true) {
  float* T = (float*)smem;
  const int tid = tidx();
  {
    const int n = tid & 63, kr = tid >> 6;
#pragma unroll 4
    for (int i = 0; i < 16; ++i) {
      const int k = kr + 4 * i;
      float v = (n0 + n < N) ? src[(size_t)(k0 + k) * N + n0 + n] : 0.f;
      if (scale) v *= scale[k0 + k];
      T[k * 65 + n] = v;
    }
  }
  __syncthreads();
  {
    const int nl = tid >> 2, kc = (tid & 3) * 16, n = n0 + nl;
    if (n < N) {
      unsigned w[8];
#pragma unroll
      for (int j = 0; j < 8; ++j) w[j] = pk2(T[(kc + 2 * j) * 65 + nl], T[(kc + 2 * j + 1) * 65 + nl]);
      const int np = perm_col(type, n);
      u16* d = dst + (tiled ? tiled_off(np, k0 + kc, K) : (size_t)np * K + k0 + kc);
      *(uint4*)d = make_uint4(w[0], w[1], w[2], w[3]);
      *(uint4*)(d + 8) = make_uint4(w[4], w[5], w[6], w[7]);
    }
  }
  __syncthreads();
}

constexpr int CONV_ITEMS = 1328 + 72 + 64 + 64 + 384 + 256 + 1024 + 1024 + 800;

__device__ __forceinline__ void convert_item(const Params& P, int l, int it, char* smem) {
  unsigned char* ws = P.ws;
  const int tid = tidx();
  if (it < 1328) { conv_tile(P.in[I_WIN] + (size_t)l * 1024 * NIN, 1024, NIN, (u16*)(ws + W_WIN), (it & 15) * 64, (it >> 4) * 64, 1, nullptr, smem); return; }
  it -= 1328;
  if (it < 72) { conv_tile(P.in[I_WQUP] + (size_t)l * 384 * 768, 384, 768, (u16*)(ws + W_WQ), (it % 6) * 64, (it / 6) * 64, 2, P.in[I_GQA] + l * 384, smem, false); return; }
  it -= 72;
  if (it < 64) { conv_tile(P.in[I_WKVUP] + (size_t)l * 256 * 1024, 256, 1024, (u16*)(ws + W_WKV), (it & 3) * 64, (it >> 2) * 64, 3, P.in[I_GKVA] + l * 256, smem, false); return; }
  it -= 64;
  if (it < 64) { conv_tile(P.in[I_WKVUP] + (size_t)l * 256 * 1024, 256, 1024, (u16*)(ws + W_WKVC), (it & 3) * 64, (it >> 2) * 64, 3, nullptr, smem, false); return; }
  it -= 64;
  if (it < 384) {
    const int br = it >> 7, t = it & 127;
    const float *pa = P.in[I_WOA], *pb = P.in[I_WOB], *pc = P.in[I_WOC];
    asm volatile("" : "+s"(pa), "+s"(pb), "+s"(pc));
    conv_tile((br == 0 ? pa : (br == 1 ? pb : pc)) + (size_t)l * 512 * 1024, 512, 1024, (u16*)(ws + W_WO3) + (size_t)br * 1024 * 512, (t & 7) * 64, (t >> 3) * 64, 0, nullptr, smem);
    return;
  }
  it -= 384;
  if (it < 256) { conv_tile(P.in[I_WOUT] + (size_t)l * 1024 * 1024, 1024, 1024, (u16*)(ws + W_WOUT), (it & 15) * 64, (it >> 4) * 64, 0, nullptr, smem); return; }
  it -= 256;
  if (it < 1024) { conv_tile(P.in[I_W1] + (size_t)l * 1024 * 4096, 1024, 4096, (u16*)(ws + W_W1), (it & 15) * 64, (it >> 4) * 64, 0, nullptr, smem); return; }
  it -= 1024;
  if (it < 1024) { conv_tile(P.in[I_W2] + (size_t)l * 4096 * 1024, 4096, 1024, (u16*)(ws + W_W2), (it & 63) * 64, (it >> 6) * 64, 0, nullptr, smem); return; }
  it -= 1024;
  if (it < 512) {
    const float* src; u16* dst; int ncol, sh;
    const float *pa = P.in[I_CAK], *pb = P.in[I_CCK], *pc = P.in[I_CCKV];
    asm volatile("" : "+s"(pa), "+s"(pb), "+s"(pc));
    if (it < 128) { src = pa; dst = (u16*)(ws + W_KCA); ncol = 128; sh = 7; }
    else if (it < 256) { it -= 128; src = pb; dst = (u16*)(ws + W_KCC); ncol = 128; sh = 7; }
    else { it -= 256; src = pc; dst = (u16*)(ws + W_CKVC); ncol = 256; sh = 8; }
    const int e = (it * 256 + tid) * 8, row = e >> sh, c = e & (ncol - 1), b = row >> 9, s = row & 511;
    const float* sp = src + ((size_t)((b * 4 + l) * 512 + s)) * ncol + c;
    const float4 a = *(const float4*)sp, bb = *(const float4*)(sp + 4);
    *(uint4*)(dst + e) = make_uint4(pk2(a.x, a.y), pk2(a.z, a.w), pk2(bb.x, bb.y), pk2(bb.z, bb.w));
    return;
  }
  it -= 512;
  if (it < 32) {
    const int e = (it * 256 + tid) * 8, row = e >> 5, c = e & 31, b = row >> 9, s = row & 511;
    const float* sp = P.in[I_CKR] + ((size_t)((b * 4 + l) * 512 + s)) * 32 + c;
    const float4 a = *(const float4*)sp, bb = *(const float4*)(sp + 4);
    *(uint4*)((u16*)(ws + W_KRC) + e) = make_uint4(pk2(a.x, a.y), pk2(a.z, a.w), pk2(bb.x, bb.y), pk2(bb.z, bb.w));
    return;
  }
  it -= 32;
  {
    const float *pa = P.in[I_CAV], *pb = P.in[I_CCV];
    asm volatile("" : "+s"(pa), "+s"(pb));
    const float* src = pa; u16* dst = (u16*)(ws + W_VCAT);
    if (it >= 128) { it -= 128; src = pb; dst = (u16*)(ws + W_VCCT); }
    const int idx = it * 256 + tid, d = idx & 63, g = (idx >> 6) & 1, b = (idx >> 7) & 3, s8 = idx >> 9;
    const float* sp = src + ((size_t)((b * 4 + l) * 512 + s8 * 8)) * 128 + g * 64 + d;
    float v[8];
#pragma unroll
    for (int j = 0; j < 8; ++j) v[j] = sp[(size_t)j * 128];
    *(uint4*)(dst + ((size_t)((b * 2 + g) * 64 + d)) * 512 + s8 * 8) = make_uint4(pk2(v[0], v[1]), pk2(v[2], v[3]), pk2(v[4], v[5]), pk2(v[6], v[7]));
  }
}

__device__ __forceinline__ void mod_item(const Params& P, int it, char* smem) {
  float* sv = (float*)smem;
  float* red = (float*)(smem + 20480);
  const int tid = tidx(), l = it / 96, n0 = (it % 96) * 64;
  for (int e = tid; e < 5120; e += 256) {
    const int v = e >> 10, k = e & 1023;
    const float c = (v == 0) ? P.in[I_CCTX][k] : P.in[I_C][(v - 1) * 1024 + k];
    sv[e] = c / (1.f + __expf(-c));
  }
  __syncthreads();
  const int kq = tid >> 4, n4 = tid & 15;
  float acc[5][4];
#pragma unroll
  for (int v = 0; v < 5; ++v)
#pragma unroll
    for (int j = 0; j < 4; ++j) acc[v][j] = 0.f;
  const float* wp = P.in[I_WMOD] + ((size_t)l * 1024 + kq * 64) * 6144 + n0 + n4 * 4;
#pragma unroll 8
  for (int k = 0; k < 64; ++k) {
    const float4 w = *(const float4*)(wp + (size_t)k * 6144);
#pragma unroll
    for (int v = 0; v < 5; ++v) {
      const float s = sv[v * 1024 + kq * 64 + k];
      acc[v][0] += s * w.x; acc[v][1] += s * w.y; acc[v][2] += s * w.z; acc[v][3] += s * w.w;
    }
  }
#pragma unroll
  for (int v = 0; v < 5; ++v)
#pragma unroll
    for (int j = 0; j < 4; ++j) red[(kq * 5 + v) * 64 + n4 * 4 + j] = acc[v][j];
  __syncthreads();
  float* mod = (float*)(P.ws + W_MOD);
  for (int e = tid; e < 320; e += 256) {
    const int v = e >> 6, n = e & 63;
    float s = P.in[I_BMOD][l * 6144 + n0 + n];
#pragma unroll
    for (int q = 0; q < 16; ++q) s += red[(q * 5 + v) * 64 + n];
    mod[((size_t)l * 5 + v) * 6144 + n0 + n] = s;
  }
  __syncthreads();
}

__device__ __forceinline__ void rows_phase(const Params& P, int mode, int l) {
  const int lane = tidx() & 63, wid = tidx() >> 6;
  const int gw = blockIdx.x * 4 + wid, nw = gridDim.x * 4;
  const float* mod = (const float*)(P.ws + W_MOD);
  u16* H = (u16*)(P.ws + W_H);
  const u16* TB = (const u16*)(P.ws + W_T);
  const bool write_h = !(mode == 2 && l == DEPTH - 1);
  const int lh = (mode == 2) ? l + 1 : l;
  const float* gpost = (mode == 1) ? P.in[I_GPOSTMIX] + l * 1024 : P.in[I_GPOSTMLP] + l * 1024;
  const float* gpre = (mode == 1) ? P.in[I_GPREMLP] + l * 1024 : P.in[I_GPREMIX] + (write_h ? lh : 0) * 1024;
  for (int row = gw; row < MT; row += nw) {
    const int v = row < MCTX ? 0 : 1 + ((row - MCTX) >> 12);
    float* xp = P.out + (size_t)row * 1024;
    float x[16];
    if (mode == 0) {
      const float* src = row < MCTX ? P.in[I_XP] + (size_t)row * 1024 : P.in[I_XS] + (size_t)(row - MCTX) * 1024;
#pragma unroll
      for (int i = 0; i < 4; ++i) { const float4 a = *(const float4*)(src + i * 256 + lane * 4); x[4 * i] = a.x; x[4 * i + 1] = a.y; x[4 * i + 2] = a.z; x[4 * i + 3] = a.w; }
    } else {
      float t[16];
      float ss = 0.f;
#pragma unroll
      for (int i = 0; i < 4; ++i) {
        const float4 a = *(const float4*)(xp + i * 256 + lane * 4);
        x[4 * i] = a.x; x[4 * i + 1] = a.y; x[4 * i + 2] = a.z; x[4 * i + 3] = a.w;
        const uint2 tb = *(const uint2*)(TB + (size_t)row * 1024 + i * 256 + lane * 4);
        t[4 * i] = bflo(tb.x); t[4 * i + 1] = bfhi(tb.x); t[4 * i + 2] = bflo(tb.y); t[4 * i + 3] = bfhi(tb.y);
      }
#pragma unroll
      for (int i = 0; i < 16; ++i) ss += t[i] * t[i];
      ss = wave_sum(ss);
      const float rstd = rsqrtf(ss * (1.f / 1024.f) + EPS);
      const float* gate = mod + ((size_t)l * 5 + v) * 6144 + (mode == 1 ? 2048 : 5120);
#pragma unroll
      for (int i = 0; i < 4; ++i) {
        const float4 gt = *(const float4*)(gate + i * 256 + lane * 4);
        const float4 gp = *(const float4*)(gpost + i * 256 + lane * 4);
        x[4 * i] += gt.x * (t[4 * i] * rstd * gp.x);
        x[4 * i + 1] += gt.y * (t[4 * i + 1] * rstd * gp.y);
        x[4 * i + 2] += gt.z * (t[4 * i + 2] * rstd * gp.z);
        x[4 * i + 3] += gt.w * (t[4 * i + 3] * rstd * gp.w);
      }
    }
#pragma unroll
    for (int i = 0; i < 4; ++i) *(float4*)(xp + i * 256 + lane * 4) = make_float4(x[4 * i], x[4 * i + 1], x[4 * i + 2], x[4 * i + 3]);
    if (write_h) {
      float ss = 0.f;
#pragma unroll
      for (int i = 0; i < 16; ++i) ss += x[i] * x[i];
      ss = wave_sum(ss);
      const float rstd = rsqrtf(ss * (1.f / 1024.f) + EPS);
      const float* mb = mod + ((size_t)lh * 5 + v) * 6144;
      const float* shp = mb + (mode == 1 ? 3072 : 0);
      const float* scp = mb + (mode == 1 ? 4096 : 1024);
#pragma unroll
      for (int i = 0; i < 4; ++i) {
        const float4 g = *(const float4*)(gpre + i * 256 + lane * 4);
        const float4 sc = *(const float4*)(scp + i * 256 + lane * 4);
        const float4 sh = *(const float4*)(shp + i * 256 + lane * 4);
        const float h0 = x[4 * i] * rstd * g.x * (1.f + sc.x) + sh.x;
        const float h1 = x[4 * i + 1] * rstd * g.y * (1.f + sc.y) + sh.y;
        const float h2 = x[4 * i + 2] * rstd * g.z * (1.f + sc.z) + sh.z;
        const float h3 = x[4 * i + 3] * rstd * g.w * (1.f + sc.w) + sh.w;
        uint2 w; w.x = pk2(h0, h1); w.y = pk2(h2, h3);
        *(uint2*)(H + tiled_off(row, i * 256 + lane * 4, 1024)) = w;
      }
    }
  }
}

#define LDS_PTR(p) ((__attribute__((address_space(3))) void*)(p))
__device__ __forceinline__ int swz4(int q) { return ((q & 1) << 1) | ((q >> 1) ^ (q & 1)); }
template <bool XT, bool WT>
__device__ __forceinline__ void gemm_core(const u16* __restrict__ X, int ldx, const u16* __restrict__ W, int K, int m0, int n0, char* smem,
                                          f32x4 (&acc)[4][4]) {
  const int tid = tidx(), lane = tid & 63, wid = tid >> 6;
  const int wn = wid >> 1, wm = wid & 1, fr = lane & 15, fq = lane >> 4;
  const int drow = wid * 16 + (lane >> 2);
  const int dch = (lane & 3) ^ swz4((lane >> 4) & 3);
  const u16* wg = W + (WT ? (size_t)(n0 + wid * 16) * K + (lane >> 2) * 32 : (size_t)(n0 + drow) * K) + dch * 8;
  const u16* xg = X + (XT ? (size_t)(m0 + wid * 16) * ldx + (lane >> 2) * 32 : (size_t)(m0 + drow) * ldx) + dch * 8;
  constexpr int KW = WT ? 512 : 32, KX = XT ? 512 : 32;
  const size_t wstep = (size_t)64 * K, xstep = (size_t)64 * ldx;
  char* dl = smem + wid * 1024 + lane * 16;
  auto issue = [&](int kt) {
    char* d = dl + (kt & 3) * 16384;
    const int kw = kt * KW, kx = kt * KX;
    __builtin_amdgcn_global_load_lds(wg + kw, LDS_PTR(d), 16, 0, 0);
    __builtin_amdgcn_global_load_lds(wg + wstep + kw, LDS_PTR(d + 4096), 16, 0, 0);
    __builtin_amdgcn_global_load_lds(xg + kx, LDS_PTR(d + 8192), 16, 0, 0);
    __builtin_amdgcn_global_load_lds(xg + xstep + kx, LDS_PTR(d + 8192 + 4096), 16, 0, 0);
  };
  const int nk = K >> 5;
  asm volatile("s_waitcnt vmcnt(0)" ::: "memory");
  __builtin_amdgcn_s_barrier();
  issue(0); issue(1); issue(2);
  const int co = (fq ^ swz4((fr >> 2) & 3)) << 4;
  const int aoff = (wn * 64 + fr) * 64 + co, boff = 8192 + (wm * 64 + fr) * 64 + co;
  bf16x8 a0[4], b0[4], a1[4], b1[4];
  asm volatile("s_waitcnt vmcnt(8)" ::: "memory");
  __builtin_amdgcn_s_barrier();
  asm volatile("" ::: "memory");
  issue(3);
#pragma unroll
  for (int i = 0; i < 4; ++i) { a0[i] = *(const bf16x8*)(smem + aoff + i * 1024); b0[i] = *(const bf16x8*)(smem + boff + i * 1024); }
#define GEMM_STEP(kt, AC, BC, AN, BN) do { \
    if ((kt) + 1 < nk) { \
      if ((kt) + 3 < nk) asm volatile("s_waitcnt vmcnt(8) lgkmcnt(0)" ::: "memory"); \
      else if ((kt) + 2 < nk) asm volatile("s_waitcnt vmcnt(4) lgkmcnt(0)" ::: "memory"); \
      else asm volatile("s_waitcnt vmcnt(0) lgkmcnt(0)" ::: "memory"); \
      __builtin_amdgcn_s_barrier(); \
      asm volatile("" ::: "memory"); \
      if ((kt) + 4 < nk) issue((kt) + 4); \
      const char* st_ = smem + (((kt) + 1) & 3) * 16384; \
      _Pragma("unroll") for (int i = 0; i < 4; ++i) { AN[i] = *(const bf16x8*)(st_ + aoff + i * 1024); BN[i] = *(const bf16x8*)(st_ + boff + i * 1024); } \
    } \
    _Pragma("unroll") for (int ni = 0; ni < 4; ++ni) \
      _Pragma("unroll") for (int mi = 0; mi < 4; ++mi) acc[ni][mi] = __builtin_amdgcn_mfma_f32_16x16x32_bf16(AC[ni], BC[mi], acc[ni][mi], 0, 0, 0); \
  } while (0)
  for (int kt = 0; kt < nk; kt += 2) {
    GEMM_STEP(kt, a0, b0, a1, b1);
    GEMM_STEP(kt + 1, a1, b1, a0, b0);
  }
#undef GEMM_STEP
}
__device__ __forceinline__ void tile_map_big(int t, int T, int ntn, int& mt, int& nt);
template <bool XT, bool WT, class Epi>
__device__ __forceinline__ void gemm_phase_big(const u16* __restrict__ X, int ldx, const u16* __restrict__ W, int K, int T, int ntn, char* smem, Epi epi) {
  int t = blockIdx.x;
  if (t >= T) return;
  const int tid = tidx(), lane = tid & 63, wid = tid >> 6;
  const int wn = wid >> 1, wm = wid & 1, fr = lane & 15, fq = lane >> 4;
  const int drow = wid * 16 + (lane >> 2);
  const int dch = (lane & 3) ^ swz4((lane >> 4) & 3);
  constexpr int KW = WT ? 512 : 32, KX = XT ? 512 : 32;
  const size_t woff = (WT ? (size_t)(wid * 16) * K + (lane >> 2) * 32 : (size_t)drow * K) + dch * 8;
  const size_t xoff = (XT ? (size_t)(wid * 16) * ldx + (lane >> 2) * 32 : (size_t)drow * ldx) + dch * 8;
  const size_t wstep = (size_t)64 * K, xstep = (size_t)64 * ldx;
  char* dl = smem + wid * 1024 + lane * 16;
  const u16 *wg, *xg;
  int rb = 0;
  auto issue = [&](int kt) {
    char* d = dl + ((rb + kt) % 3) * 24576;
    const int kw = kt * KW, kx = kt * KX;
    __builtin_amdgcn_global_load_lds(wg + kw, LDS_PTR(d), 16, 0, 0);
    __builtin_amdgcn_global_load_lds(wg + wstep + kw, LDS_PTR(d + 4096), 16, 0, 0);
    __builtin_amdgcn_global_load_lds(xg + kx, LDS_PTR(d + 8192), 16, 0, 0);
    __builtin_amdgcn_global_load_lds(xg + xstep + kx, LDS_PTR(d + 8192 + 4096), 16, 0, 0);
    __builtin_amdgcn_global_load_lds(xg + 2 * xstep + kx, LDS_PTR(d + 8192 + 8192), 16, 0, 0);
    __builtin_amdgcn_global_load_lds(xg + 3 * xstep + kx, LDS_PTR(d + 8192 + 12288), 16, 0, 0);
  };
  const int nk = K >> 5;
  const int co = (fq ^ swz4((fr >> 2) & 3)) << 4;
  const int aoff = (wn * 64 + fr) * 64 + co, boff = 8192 + (wm * 128 + fr) * 64 + co;
  int mt, nt;
  tile_map_big(t, T, ntn, mt, nt);
  wg = W + (size_t)(nt * 128) * K + woff;
  xg = X + (size_t)(mt * 256) * ldx + xoff;
  asm volatile("s_waitcnt vmcnt(0)" ::: "memory");
  __builtin_amdgcn_s_barrier();
  issue(0); issue(1);
  for (;;) {
    f32x4 acc[2][4][4];
#pragma unroll
    for (int mh = 0; mh < 2; ++mh)
#pragma unroll
      for (int i = 0; i < 4; ++i)
#pragma unroll
        for (int j = 0; j < 4; ++j) acc[mh][i][j] = (f32x4){0.f, 0.f, 0.f, 0.f};
    for (int kt = 0; kt < nk; ++kt) {
      if (kt + 1 < nk) asm volatile("s_waitcnt vmcnt(6)" ::: "memory");
      else asm volatile("s_waitcnt vmcnt(0)" ::: "memory");
      __builtin_amdgcn_s_barrier();
      asm volatile("" ::: "memory");
      if (kt + 2 < nk) issue(kt + 2);
      const char* st = smem + ((rb + kt) % 3) * 24576;
      bf16x8 a[4], b[8];
#pragma unroll
      for (int i = 0; i < 4; ++i) a[i] = *(const bf16x8*)(st + aoff + i * 1024);
#pragma unroll
      for (int i = 0; i < 8; ++i) b[i] = *(const bf16x8*)(st + boff + i * 1024);
#pragma unroll
      for (int mh = 0; mh < 2; ++mh)
#pragma unroll
        for (int ni = 0; ni < 4; ++ni)
#pragma unroll
          for (int mi = 0; mi < 4; ++mi) acc[mh][ni][mi] = __builtin_amdgcn_mfma_f32_16x16x32_bf16(a[ni], b[mh * 4 + mi], acc[mh][ni][mi], 0, 0, 0);
    }
    rb = (rb + nk) % 3;
    const int m0 = mt * 256, n0 = nt * 128;
    const int tn = t + gridDim.x;
    if (tn < T) {
      tile_map_big(tn, T, ntn, mt, nt);
      wg = W + (size_t)(nt * 128) * K + woff;
      xg = X + (size_t)(mt * 256) * ldx + xoff;
      issue(0); issue(1);
    }
    epi(m0, n0, acc);
    if (tn >= T) break;
    t = tn;
  }
}
__device__ __forceinline__ void tile_map_big(int t, int T, int ntn, int& mt, int& nt) {
  const int tp = (t & 7) * (T >> 3) + (t >> 3);
  const int g = 6 * ntn, ms = tp / g, rem = tp - ms * g;
  nt = rem / 6; mt = ms * 6 + (rem - nt * 6);
}
__device__ __forceinline__ void zero_acc(f32x4 (&acc)[4][4]) {
#pragma unroll
  for (int i = 0; i < 4; ++i)
#pragma unroll
    for (int j = 0; j < 4; ++j) acc[i][j] = (f32x4){0.f, 0.f, 0.f, 0.f};
}
__device__ __forceinline__ void tile_map(int t, int T, int ntn, int& mt, int& nt) {
  const int tp = (t & 7) * (T >> 3) + (t >> 3);
  const int g = 8 * ntn, ms = tp / g, rem = tp - ms * g;
  nt = rem >> 3; mt = ms * 8 + (rem & 7);
}

struct WavePos { int nb, mb, fr, fq; };
__device__ __forceinline__ WavePos wave_pos(int m0, int n0) {
  const int lane = tidx() & 63, wid = tidx() >> 6;
  WavePos w; w.nb = n0 + (wid >> 1) * 64; w.mb = m0 + (wid & 1) * 64; w.fr = lane & 15; w.fq = lane >> 4; return w;
}
__device__ __forceinline__ WavePos wave_pos_big(int m0, int n0, int mh) {
  const int lane = tidx() & 63, wid = tidx() >> 6;
  WavePos w; w.nb = n0 + (wid >> 1) * 64; w.mb = m0 + (wid & 1) * 128 + mh * 64; w.fr = lane & 15; w.fq = lane >> 4; return w;
}

__device__ __forceinline__ void store_all(u16* C, int ldc, int c0, const WavePos& w, f32x4 (&acc)[4][4]) {
#pragma unroll
  for (int mi = 0; mi < 4; ++mi) {
    u16* rp = C + (size_t)(w.mb + mi * 16 + w.fr) * ldc + c0 + w.fq * 4;
#pragma unroll
    for (int ni = 0; ni < 4; ++ni) st4bf(rp + ni * 16, acc[ni][mi]);
  }
}
__device__ __forceinline__ void store_all_tiled(u16* C, int K, int c0, const WavePos& w, f32x4 (&acc)[4][4]) {
#pragma unroll
  for (int mi = 0; mi < 4; ++mi) {
    const int m = w.mb + mi * 16 + w.fr;
#pragma unroll
    for (int ni = 0; ni < 4; ++ni) st4bf(C + tiled_off(m, c0 + ni * 16 + w.fq * 4, K), acc[ni][mi]);
  }
}
__device__ __forceinline__ void store_ctx_f32(float* outb, int ncols, int c0, int l, const WavePos& w, f32x4 (&acc)[4][4], int nimax) {
#pragma unroll
  for (int mi = 0; mi < 4; ++mi) {
    const int m = w.mb + mi * 16 + w.fr, b = m >> 8, s = m & 255;
    float* rp = outb + ((size_t)((b * 4 + l) * 256 + s)) * ncols + c0 + w.fq * 4;
#pragma unroll
    for (int ni = 0; ni < 4; ++ni) if (ni < nimax) *(float4*)(rp + ni * 16) = make_float4(acc[ni][mi][0], acc[ni][mi][1], acc[ni][mi][2], acc[ni][mi][3]);
  }
}
__device__ __forceinline__ void store_vt(u16* VT, int NH, int head, const WavePos& w, f32x4 (&acc)[4][4]) {
#pragma unroll
  for (int mi = 0; mi < 4; ++mi) {
    const int m = w.mb + mi * 16 + w.fr;
    u16* bp; size_t stride;
    if (m < MCTX) { const int b = m >> 8, s = m & 255; bp = VT + ((size_t)(b * NH + head) * 64) * 256 + s; stride = 256; }
    else { const int ml = m - MCTX, b = ml >> 12, t = ml & 4095; bp = VT + (size_t)MCTX * NH * 64 + ((size_t)(b * NH + head) * 64) * 4096 + t; stride = 4096; }
#pragma unroll
    for (int ni = 0; ni < 4; ++ni)
#pragma unroll
      for (int j = 0; j < 4; ++j) {
        const int d = ni * 16 + w.fq * 4 + j;
        bp[(size_t)d * stride] = (u16)(pk2(acc[ni][mi][j], 0.f) & 0xffffu);
      }
  }
}
__device__ __forceinline__ void rope64(const WavePos& w, f32x4 (&acc)[4][4]) {
  float inv[4];
#pragma unroll
  for (int j = 0; j < 4; ++j) inv[j] = exp2f(-(float)(w.fq * 4 + j) * (L2THETA / 16.f));
#pragma unroll
  for (int mi = 0; mi < 4; ++mi) {
    const int t = (w.mb + mi * 16 + w.fr - MCTX) & 4095;
    const float pr = (float)(t >> 6), pc = (float)(t & 63);
#pragma unroll
    for (int hf = 0; hf < 2; ++hf) {
      const float pos = hf ? pc : pr;
#pragma unroll
      for (int j = 0; j < 4; ++j) {
        const float a = pos * inv[j], sn = __sinf(a), cs = __cosf(a);
        const float x1 = acc[2 * hf][mi][j], x2 = acc[2 * hf + 1][mi][j];
        acc[2 * hf][mi][j] = x1 * cs - x2 * sn;
        acc[2 * hf + 1][mi][j] = x2 * cs + x1 * sn;
      }
    }
  }
}
__device__ __forceinline__ void rope32(const WavePos& w, f32x4 (&acc)[4][4], int nimax) {
  float inv[4];
#pragma unroll
  for (int j = 0; j < 4; ++j) inv[j] = exp2f(-(float)((w.fq & 1) * 4 + j) * (L2THETA / 8.f));
  const bool second = w.fq >= 2;
#pragma unroll
  for (int mi = 0; mi < 4; ++mi) {
    const int t = (w.mb + mi * 16 + w.fr - MCTX) & 4095;
    const float pr = (float)(t >> 6), pc = (float)(t & 63);
#pragma unroll
    for (int ni = 0; ni < 4; ++ni) {
      if (ni < nimax) {
        const float pos = (ni & 1) ? pc : pr;
#pragma unroll
        for (int j = 0; j < 4; ++j) {
          const float a = pos * inv[j], sn = __sinf(a), cs = __cosf(a);
          const float x = acc[ni][mi][j], o = __shfl_xor(x, 32);
          acc[ni][mi][j] = second ? (x * cs + o * sn) : (x * cs - o * sn);
        }
      }
    }
  }
}
__device__ __forceinline__ void row_ssq(f32x4 (&acc)[4][4], float (&ss)[4]) {
#pragma unroll
  for (int mi = 0; mi < 4; ++mi) {
    float s = 0.f;
#pragma unroll
    for (int ni = 0; ni < 4; ++ni)
#pragma unroll
      for (int j = 0; j < 4; ++j) s += acc[ni][mi][j] * acc[ni][mi][j];
    s += __shfl_xor(s, 16);
    s += __shfl_xor(s, 32);
    ss[mi] = s;
  }
}
__device__ __forceinline__ void head_norm(const WavePos& w, f32x4 (&acc)[4][4], const float* g) {
  float ss[4];
  row_ssq(acc, ss);
#pragma unroll
  for (int ni = 0; ni < 4; ++ni) {
    const float4 gv = *(const float4*)(g + ni * 16 + w.fq * 4);
#pragma unroll
    for (int mi = 0; mi < 4; ++mi) {
      const float r = rsqrtf(ss[mi] * (1.f / 64.f) + EPS);
      acc[ni][mi][0] *= r * gv.x; acc[ni][mi][1] *= r * gv.y; acc[ni][mi][2] *= r * gv.z; acc[ni][mi][3] *= r * gv.w;
    }
  }
}
__device__ __forceinline__ void ssq_atomic(const WavePos& w, f32x4 (&acc)[4][4], float* ssq) {
  float ss[4];
  row_ssq(acc, ss);
  if (w.fq == 0) {
#pragma unroll
    for (int mi = 0; mi < 4; ++mi) atomicAdd(ssq + w.mb + mi * 16 + w.fr, ss[mi]);
  }
}

__device__ __forceinline__ void scale_acc(f32x4 (&acc)[4][4], float f) {
#pragma unroll
  for (int ni = 0; ni < 4; ++ni)
#pragma unroll
    for (int mi = 0; mi < 4; ++mi) acc[ni][mi] *= f;
}
__device__ __forceinline__ void epi_win(const Params& P, int l, const WavePos& w, f32x4 (&acc)[4][4], bool do_atomic = true) {
  unsigned char* ws = P.ws;
  const bool lat = w.mb >= MCTX;
  const int nb = w.nb;
  float* ssq = (float*)(ws + W_SSQ) + (size_t)l * 2 * MT;
  if (nb < 512) { if (lat) rope64(w, acc); scale_acc(acc, QSC_AC); store_all_tiled((u16*)(ws + W_QA), 512, nb, w, acc); }
  else if (nb < 640) {
    if (!lat) store_ctx_f32(P.out + O_NAK, 128, nb - 512, l, w, acc, 4); else rope64(w, acc);
    store_all((u16*)(ws + W_KA), 128, nb - 512, w, acc);
  } else if (nb < 768) {
    if (!lat) store_ctx_f32(P.out + O_NAV, 128, nb - 640, l, w, acc, 4);
    store_vt((u16*)(ws + W_VAT), 2, (nb - 640) >> 6, w, acc);
  } else if (nb < 1152) { store_all((u16*)(ws + W_QBD), 384, nb - 768, w, acc); if (do_atomic) ssq_atomic(w, acc, ssq); }
  else if (nb < 1408) {
    store_all((u16*)(ws + W_KVBD), 256, nb - 1152, w, acc); if (do_atomic) ssq_atomic(w, acc, ssq + MT);
    if (!lat) store_ctx_f32(P.out + O_NCKV, 256, nb - 1152, l, w, acc, 4);
  } else if (nb < 1920) { head_norm(w, acc, P.in[I_GQC] + l * 64); if (lat) rope64(w, acc); scale_acc(acc, QSC_AC); store_all_tiled((u16*)(ws + W_QC), 512, nb - 1408, w, acc); }
  else if (nb < 2048) {
    head_norm(w, acc, P.in[I_GKC] + l * 64);
    if (!lat) store_ctx_f32(P.out + O_NCK, 128, nb - 1920, l, w, acc, 4); else rope64(w, acc);
    store_all((u16*)(ws + W_KC), 128, nb - 1920, w, acc);
  } else if (nb < 2176) {
    if (!lat) store_ctx_f32(P.out + O_NCV, 128, nb - 2048, l, w, acc, 4);
    store_vt((u16*)(ws + W_VCT), 2, (nb - 2048) >> 6, w, acc);
  } else if (nb < 5248) {
#pragma unroll
    for (int ni = 0; ni < 4; ++ni)
#pragma unroll
      for (int mi = 0; mi < 4; ++mi)
#pragma unroll
        for (int j = 0; j < 4; ++j) acc[ni][mi][j] = __builtin_amdgcn_rcpf(1.f + __builtin_amdgcn_exp2f(-LOG2E * acc[ni][mi][j]));
    store_all((u16*)(ws + W_GATES), 3072, nb - 2176, w, acc);
  } else if (nb == 5248) {
    if (!lat) store_ctx_f32(P.out + O_NKR, 32, 0, l, w, acc, 2); else rope32(w, acc, 2);
    u16* KR = (u16*)(ws + W_KR);
#pragma unroll
    for (int mi = 0; mi < 4; ++mi) {
      u16* rp = KR + (size_t)(w.mb + mi * 16 + w.fr) * 32 + w.fq * 4;
      st4bf(rp, acc[0][mi]); st4bf(rp + 16, acc[1][mi]);
    }
  }
}


template <int MIX>
__device__ __forceinline__ void attn_unit(const Params& P, int l, bool lat, int b, int h, int qb, char* smem, bool dummy) {
  unsigned char* ws = P.ws;
  const int tid = tidx(), lane = tid & 63, wv = tid >> 6, r = lane & 31, hh = lane >> 5;
  constexpr int NS = (MIX == 1) ? 6 : 4;
  const int g = h >> 2;
  const int rq0 = lat ? MCTX + b * 4096 + qb * 128 : b * 256 + qb * 128;
  const int qrow = rq0 + wv * 32 + r;
  u16* qbase; int qld;
  if (MIX == 0) { qbase = (u16*)(ws + W_QA); qld = 512; } else if (MIX == 1) { qbase = (u16*)(ws + W_QB); qld = 768; } else { qbase = (u16*)(ws + W_QC); qld = 512; }
  bf16x8 qf[NS];
  {
#pragma unroll
    for (int s = 0; s < 4; ++s) qf[s] = *(const bf16x8*)(qbase + tiled_off(qrow, h * 64 + s * 16 + hh * 8, qld));
    if (MIX == 1) {
#pragma unroll
      for (int s = 4; s < NS; ++s) qf[s] = *(const bf16x8*)(qbase + tiled_off(qrow, 512 + h * 32 + (s - 4) * 16 + hh * 8, qld));
    }
  }
  constexpr int KST = (MIX == 1) ? 512 : 128;
  const u16 *K0, *K1, *R0 = nullptr, *R1p = nullptr, *V0, *V1;
  int vs0, vs1, nt0, nt1, pos1 = 0;
  if (!lat) {
    const int r0 = b * 256;
    if (MIX == 0) { K0 = (const u16*)(ws + W_KA) + (size_t)r0 * 128 + g * 64; V0 = (const u16*)(ws + W_VAT) + ((size_t)(b * 2 + g) * 64) * 256; }
    else if (MIX == 1) { K0 = (const u16*)(ws + W_KBN) + (size_t)r0 * 512 + h * 64; R0 = (const u16*)(ws + W_KR) + (size_t)r0 * 32; V0 = (const u16*)(ws + W_VBT) + ((size_t)(b * 8 + h) * 64) * 256; }
    else { K0 = (const u16*)(ws + W_KC) + (size_t)r0 * 128 + g * 64; V0 = (const u16*)(ws + W_VCT) + ((size_t)(b * 2 + g) * 64) * 256; }
    vs0 = 256; nt0 = 4;
    K1 = K0; R1p = R0; V1 = V0; vs1 = 256; nt1 = 0;
  } else {
    const int c0 = b * 512;
    int k0 = 0, k1 = 4096;
    if (MIX == 0) { k0 = (qb > 0 ? qb - 1 : 0) * 128; k1 = (qb + 2 < 32 ? qb + 2 : 32) * 128; }
    const int r0 = MCTX + b * 4096 + k0;
    if (MIX == 0) {
      K0 = (const u16*)(ws + W_KCA) + (size_t)c0 * 128 + g * 64; V0 = (const u16*)(ws + W_VCAT) + ((size_t)(b * 2 + g) * 64) * 512;
      K1 = (const u16*)(ws + W_KA) + (size_t)r0 * 128 + g * 64;
      V1 = (const u16*)(ws + W_VAT) + (size_t)MCTX * 128 + ((size_t)(b * 2 + g) * 64) * 4096 + k0;
    } else if (MIX == 1) {
      K0 = (const u16*)(ws + W_KBNC) + (size_t)c0 * 512 + h * 64; R0 = (const u16*)(ws + W_KRC) + (size_t)c0 * 32; V0 = (const u16*)(ws + W_VBTC) + ((size_t)(b * 8 + h) * 64) * 512;
      K1 = (const u16*)(ws + W_KBN) + (size_t)r0 * 512 + h * 64; R1p = (const u16*)(ws + W_KR) + (size_t)r0 * 32;
      V1 = (const u16*)(ws + W_VBT) + (size_t)MCTX * 512 + ((size_t)(b * 8 + h) * 64) * 4096 + k0;
    } else {
      K0 = (const u16*)(ws + W_KCC) + (size_t)c0 * 128 + g * 64; V0 = (const u16*)(ws + W_VCCT) + ((size_t)(b * 2 + g) * 64) * 512;
      K1 = (const u16*)(ws + W_KC) + (size_t)r0 * 128 + g * 64;
      V1 = (const u16*)(ws + W_VCT) + (size_t)MCTX * 128 + ((size_t)(b * 2 + g) * 64) * 4096 + k0;
    }
    vs0 = 512; nt0 = 8; vs1 = 4096; nt1 = (k1 - k0) >> 6; pos1 = k0;
  }
  const int ntot = nt0 + nt1;

  float m_run = -1e30f, l_run = 0.f;
  if (MIX == 0) { m_run = P.in[I_SINK][l * 8 + h] * LOG2E; l_run = (hh == 0) ? 1.f : 0.f; }
  f32x16 o0, o1, mref;
#pragma unroll
  for (int i = 0; i < 16; ++i) { o0[i] = 0.f; o1[i] = 0.f; mref[i] = 0.f; }

  const int krow = wv * 8 + (lane >> 3);
  const int kch = (lane & 7) ^ (((lane >> 4) + 4 * (wv & 1)) & 7);
  const int rrow = wv * 16 + (lane >> 2), rch = (lane & 3) ^ ((lane >> 4) & 3);
  char* dl = smem + wv * 1024 + lane * 16;
  const u16* kq = K0 + (size_t)krow * KST + kch * 8;
  const u16* vq = V0 + (size_t)krow * vs0 + kch * 8;
  const u16* rq = (MIX == 1) ? R0 + (size_t)rrow * 32 + rch * 8 : nullptr;
  int vhi = 32 * vs0, nreq = 0, slot_off = 0;
  auto issue = [&](int) {
    char* d = dl + slot_off;
    __builtin_amdgcn_global_load_lds(kq, LDS_PTR(d), 16, 0, 0);
    __builtin_amdgcn_global_load_lds(kq + 32 * KST, LDS_PTR(d + 4096), 16, 0, 0);
    __builtin_amdgcn_global_load_lds(vq, LDS_PTR(d + 12288), 16, 0, 0);
    __builtin_amdgcn_global_load_lds(vq + vhi, LDS_PTR(d + 12288 + 4096), 16, 0, 0);
    if (MIX == 1) __builtin_amdgcn_global_load_lds(rq, LDS_PTR(d + 8192), 16, 0, 0);
    kq += 64 * KST; vq += 64; if (MIX == 1) rq += 64 * 32;
    slot_off = (slot_off == 40960) ? 0 : slot_off + 20480;
    if (++nreq == nt0) {
      kq = K1 + (size_t)krow * KST + kch * 8;
      vq = V1 + (size_t)krow * vs1 + kch * 8;
      if (MIX == 1) rq = R1p + (size_t)rrow * 32 + rch * 8;
      vhi = 32 * vs1;
    }
  };
  const int keyr = (r & 0x13) | ((r & 4) << 1) | ((r & 8) >> 1);
  const int qpos = qb * 128 + wv * 32 + r;

#pragma unroll
  for (int s = 0; s < NS; ++s) asm volatile("" :: "v"(qf[s]));
  asm volatile("s_waitcnt vmcnt(0)" ::: "memory");
  __builtin_amdgcn_s_barrier();
  issue(0);
  issue(1);
  int rcur = 0;
  for (int ti = 0; ti < ntot; ++ti) {
    if (ti + 1 < ntot) { if (MIX == 1) asm volatile("s_waitcnt vmcnt(5)" ::: "memory"); else asm volatile("s_waitcnt vmcnt(4)" ::: "memory"); }
    else asm volatile("s_waitcnt vmcnt(0)" ::: "memory");
    __builtin_amdgcn_s_barrier();
    asm volatile("" ::: "memory");
    if (ti + 2 < ntot && !(PROBE_VAR == 2 && dummy)) issue(ti + 2);
    const int cur = rcur;
    rcur = (rcur == 40960) ? 0 : rcur + 20480;
    bf16x8 kf[2 * NS], vf[8];
#pragma unroll
    for (int s = 0; s < NS; ++s) {
#pragma unroll
      for (int kt2 = 0; kt2 < 2; ++kt2) {
        const int key = kt2 * 32 + keyr;
        int addr;
        if (s < 4) addr = cur + key * 128 + (((s * 2 + hh) ^ ((key >> 1) & 7)) << 4);
        else addr = cur + 8192 + key * 64 + ((((s - 4) * 2 + hh) ^ ((key >> 2) & 3)) << 4);
        kf[2 * s + kt2] = *(const bf16x8*)(smem + addr);
      }
    }
#pragma unroll
    for (int ks = 0; ks < 4; ++ks) {
#pragma unroll
      for (int dt = 0; dt < 2; ++dt) {
        const int d = dt * 32 + r;
        vf[2 * ks + dt] = *(const bf16x8*)(smem + cur + 12288 + d * 128 + (((ks * 2 + hh) ^ ((d >> 1) & 7)) << 4));
      }
    }
    f32x16 s0, s1;
    s0 = __builtin_amdgcn_mfma_f32_32x32x16_bf16(kf[0], qf[0], mref, 0, 0, 0);
    s1 = __builtin_amdgcn_mfma_f32_32x32x16_bf16(kf[1], qf[0], mref, 0, 0, 0);
#pragma unroll
    for (int s = 1; s < NS; ++s) {
      s0 = __builtin_amdgcn_mfma_f32_32x32x16_bf16(kf[2 * s], qf[s], s0, 0, 0, 0);
      s1 = __builtin_amdgcn_mfma_f32_32x32x16_bf16(kf[2 * s + 1], qf[s], s1, 0, 0, 0);
    }
    if (MIX == 0 && ti >= nt0) {
      const int kb = pos1 + (ti - nt0) * 64;
      const int qw = qb * 128 + __builtin_amdgcn_readfirstlane(wv) * 32;
      const bool inside = (kb + 63 - qw <= 128) && (qw + 31 - kb <= 128);
      const int kp0 = kb + 8 * hh;
      if (!inside) {
#pragma unroll
      for (int i = 0; i < 16; ++i) {
        const int ko = 16 * (i >> 3) + (i & 7);
        int d0 = qpos - (kp0 + ko); d0 = d0 < 0 ? -d0 : d0;
        int d1 = qpos - (kp0 + 32 + ko); d1 = d1 < 0 ? -d1 : d1;
        if (d0 > 128) s0[i] = -1e30f;
        if (d1 > 128) s1[i] = -1e30f;
      }
      }
    }
    if (ti == 0) {
      float mx = s0[0];
#pragma unroll
      for (int i = 1; i < 16; ++i) mx = fmaxf(mx, s0[i]);
#pragma unroll
      for (int i = 0; i < 16; ++i) mx = fmaxf(mx, s1[i]);
      mx = fmaxf(mx, __shfl_xor(mx, 32));
      const float m_new = fmaxf(m_run, mx);
      l_run *= __builtin_amdgcn_exp2f(m_run - m_new);
      m_run = m_new;
#pragma unroll
      for (int i = 0; i < 16; ++i) { s0[i] -= m_new; s1[i] -= m_new; mref[i] = -m_new; }
    }
    f32x2_t ps2 = {0.f, 0.f};
#pragma unroll
    for (int i = 0; i < 16; i += 2) {
      f32x2_t v = {__builtin_amdgcn_exp2f(s0[i]), __builtin_amdgcn_exp2f(s0[i + 1])};
      ps2 += v; s0[i] = v[0]; s0[i + 1] = v[1];
    }
#pragma unroll
    for (int i = 0; i < 16; i += 2) {
      f32x2_t v = {__builtin_amdgcn_exp2f(s1[i]), __builtin_amdgcn_exp2f(s1[i + 1])};
      ps2 += v; s1[i] = v[0]; s1[i + 1] = v[1];
    }
    float psum = ps2[0] + ps2[1];
    if (__builtin_amdgcn_ballot_w64(psum > 4096.f) != 0ull) {
      float pm = s0[0];
#pragma unroll
      for (int i = 1; i < 16; ++i) pm = fmaxf(pm, s0[i]);
#pragma unroll
      for (int i = 0; i < 16; ++i) pm = fmaxf(pm, s1[i]);
      pm = fmaxf(fmaxf(pm, __shfl_xor(pm, 32)), 1.f);
      const float f = 1.f / pm;
      m_run += __builtin_amdgcn_logf(pm);
#pragma unroll
      for (int i = 0; i < 16; ++i) mref[i] = -m_run;
      psum *= f; l_run *= f;
#pragma unroll
      for (int i = 0; i < 16; ++i) { s0[i] *= f; s1[i] *= f; o0[i] *= f; o1[i] *= f; }
    }
    l_run += psum;
    bf16x8 pb[4];
#pragma unroll
    for (int u = 0; u < 2; ++u) {
      union { bf16x8 v; unsigned w[4]; } t0, t1;
#pragma unroll
      for (int j = 0; j < 4; ++j) { t0.w[j] = pk2(s0[8 * u + 2 * j], s0[8 * u + 2 * j + 1]); t1.w[j] = pk2(s1[8 * u + 2 * j], s1[8 * u + 2 * j + 1]); }
      pb[u] = t0.v; pb[2 + u] = t1.v;
    }
#pragma unroll
    for (int ks = 0; ks < 4; ++ks) {
#pragma unroll
      for (int dt = 0; dt < 2; ++dt) {
        if (dt == 0) o0 = __builtin_amdgcn_mfma_f32_32x32x16_bf16(vf[2 * ks], pb[ks], o0, 0, 0, 0);
        else o1 = __builtin_amdgcn_mfma_f32_32x32x16_bf16(vf[2 * ks + 1], pb[ks], o1, 0, 0, 0);
      }
    }
  }
  const float lt = l_run + __shfl_xor(l_run, 32);
  const float inv = 1.f / lt;
  u16* ob = dummy ? (u16*)(ws + W_H) : qbase;
#pragma unroll
  for (int i4 = 0; i4 < 4; ++i4) {
    f32x4 a = {o0[4 * i4] * inv, o0[4 * i4 + 1] * inv, o0[4 * i4 + 2] * inv, o0[4 * i4 + 3] * inv};
    f32x4 c = {o1[4 * i4] * inv, o1[4 * i4 + 1] * inv, o1[4 * i4 + 2] * inv, o1[4 * i4 + 3] * inv};
    st4bf(ob + tiled_off(qrow, h * 64 + 4 * hh + 8 * i4, qld), a);
    st4bf(ob + tiled_off(qrow, h * 64 + 32 + 4 * hh + 8 * i4, qld), c);
  }
}

__device__ __forceinline__ void attn_phase(const Params& P, int l, char* smem, bool dummy) {
  for (int i = blockIdx.x; i < 4608; i += gridDim.x) {
    int grp, b, h, qb; bool lat;
    if (i < 3072) {
      const int j = i & 1023, jp = (j & 7) * 128 + (j >> 3);
      grp = i >> 10; lat = true; b = jp >> 8; h = (jp >> 5) & 7; qb = jp & 31;
    } else {
      const int k = i - 3072, j = k & 511, jp = (j & 7) * 64 + (j >> 3);
      grp = k >> 9; lat = false; b = jp >> 4; h = (jp >> 1) & 7; qb = jp & 1;
    }
    if (grp == 0) attn_unit<1>(P, l, lat, b, h, qb, smem, dummy);
    else if (grp == 1) attn_unit<2>(P, l, lat, b, h, qb, smem, dummy);
    else attn_unit<0>(P, l, lat, b, h, qb, smem, dummy);
  }
}


#define XB_TMO      128
#define XB_XCNT(j)  (256  + 64 * (j))
#define XB_XSUB(j)  (1280 + 64 * (j))
#define XB_XGEN(j)  (2304 + 64 * (j))
#define XB_TOP      3328
#define XB_TOPGEN   3392
#define XCD_BAR_WORDS 3456
#define XB_SPIN_CAP (1u << 20)
__device__ __forceinline__ unsigned xb_ld(unsigned* p) { return __hip_atomic_load(p, __ATOMIC_RELAXED, __HIP_MEMORY_SCOPE_AGENT); }
__device__ __forceinline__ unsigned xb_add(unsigned* p, unsigned v) { return __hip_atomic_fetch_add(p, v, __ATOMIC_RELAXED, __HIP_MEMORY_SCOPE_AGENT); }
__device__ __forceinline__ unsigned xb_xcc_id() { return (unsigned)__builtin_amdgcn_s_getreg((3 << 11) | 20) & 0xFu; }
#define XB_SPIN(cond, bar) do { unsigned _sp = 0; while (cond) { __builtin_amdgcn_s_sleep(1); \
    if ((++_sp & 255u) == 0u) { if (xb_ld(&(bar)[XB_TMO])) break; if (_sp > XB_SPIN_CAP) { atomicAdd(&(bar)[XB_TMO], 1u); break; } } } } while (0)
__device__ __forceinline__ void xcd_barrier_complete(unsigned* bar, unsigned x, unsigned& nloc, unsigned& nx) {
  const unsigned G = gridDim.x;
  unsigned sum, cnt, mine, sp = 0u;
  for (;;) {
    sum = 0u; cnt = 0u; mine = 0u;
#pragma unroll
    for (unsigned j = 0; j < 16; ++j) { const unsigned c = xb_ld(&bar[XB_XCNT(j)]); sum += c; cnt += (c > 0u) ? 1u : 0u; mine = (j == x) ? c : mine; }
    if (sum == G) break;
    __builtin_amdgcn_s_sleep(1);
    if ((++sp & 255u) == 0u) { if (xb_ld(&bar[XB_TMO])) break; if (sp > XB_SPIN_CAP) { atomicAdd(&bar[XB_TMO], 1u); break; } }
  }
  nloc = mine > 0u ? mine : 1u; nx = cnt > 0u ? cnt : 1u;
}
__device__ __forceinline__ void xcd_barrier(unsigned* bar, unsigned x, unsigned& nloc, unsigned& nx) {
  asm volatile("s_waitcnt vmcnt(0)" ::: "memory");
  __syncthreads();
  if (threadIdx.x == 0) {
    __builtin_amdgcn_s_waitcnt(0);
    if (nloc == 0u) xcd_barrier_complete(bar, x, nloc, nx);
    const unsigned old = xb_add(&bar[XB_XSUB(x)], 1u);
    const unsigned gen = old / nloc;
    if (old + 1u == (gen + 1u) * nloc) {
      __builtin_amdgcn_fence(__ATOMIC_RELEASE, "agent");
      asm volatile("s_waitcnt vmcnt(0)" ::: "memory");
      const unsigned og = xb_add(&bar[XB_TOP], 1u);
      const unsigned tg = og / nx;
      if (og + 1u == (tg + 1u) * nx) xb_add(&bar[XB_TOPGEN], 1u);
      else XB_SPIN(xb_ld(&bar[XB_TOPGEN]) == tg, bar);
      __builtin_amdgcn_fence(__ATOMIC_ACQUIRE, "agent");
      xb_add(&bar[XB_XGEN(x)], 1u);
      asm volatile("s_waitcnt vmcnt(0)" ::: "memory");
    } else {
      XB_SPIN(xb_ld(&bar[XB_XGEN(x)]) == gen, bar);
      __builtin_amdgcn_fence(__ATOMIC_ACQUIRE, "agent");
      asm volatile("s_waitcnt vmcnt(0)" ::: "memory");
    }
  }
  __syncthreads();
}

constexpr int NPHASE = 2 + 9 * DEPTH;
constexpr int LDS_BYTES = 73728;

__global__ void __launch_bounds__(256, 2) fwd_kernel(Params PA, int ph_lo, int ph_hi) {
  extern __shared__ __attribute__((aligned(16))) char smem[];
  const Params& P = PA;
  unsigned char* ws = P.ws;
#if MK_COOP
  unsigned* bar = (unsigned*)(ws + W_BAR);
  const unsigned xb_x = xb_xcc_id();
  unsigned xb_nloc = 0u, xb_nx = 0u;
  if (threadIdx.x == 0) (void)xb_add(&bar[XB_XCNT(xb_x)], 1u);
#endif
  for (int ph = ph_lo; ph < ph_hi; ++ph) {
    if (ph == 0) {
      const int nitems = 384 + 192 + CONV_ITEMS;
      for (int it = blockIdx.x; it < nitems; it += gridDim.x) {
        if (it < 384) mod_item(P, it, smem);
        else if (it < 576) { float4* z = (float4*)(ws + W_SSQ) + (size_t)(it - 384) * 256 + tidx(); *z = make_float4(0.f, 0.f, 0.f, 0.f); }
        else convert_item(P, 0, it - 576, smem);
      }
    } else if (ph == 1) {
#if PROBE_DUP == 1
      rows_phase(P, 0, 0);
      xcd_barrier(bar, xb_x, xb_nloc, xb_nx);
      for (int it = blockIdx.x; it < CONV_ITEMS; it += gridDim.x) convert_item(P, 0, it, smem);
      xcd_barrier(bar, xb_x, xb_nloc, xb_nx);
#endif
      rows_phase(P, 0, 0);
    } else {
      const int l = (ph - 2) / 9, sub = (ph - 2) % 9;
#if PROBE_SUB >= 0
      for (int prep = 0; prep < ((sub == PROBE_SUB) ? 2 : 1); ++prep) {
      if (prep) xcd_barrier(bar, xb_x, xb_nloc, xb_nx);
#endif
      if (sub == 0) {
        constexpr int NTN = NINP / 128, T = (MT / 256) * NTN;
        gemm_phase_big<true, true>((const u16*)(ws + W_H), 1024, (const u16*)(ws + W_WIN), 1024, T, NTN, smem,
          [&](int m0, int n0, f32x4 (&acc)[2][4][4]) {
#pragma unroll
            for (int mh = 0; mh < 2; ++mh) { const WavePos w = wave_pos_big(m0, n0, mh); epi_win(P, l, w, acc[mh], PROBE_FIRST); }
          });
      } else if (sub == 1) {
        constexpr int T0 = 192 * 6, T1 = 192 * 8, T2 = 16 * 8;
        const float* ssq = (const float*)(ws + W_SSQ) + (size_t)l * 2 * MT;
        for (int t = blockIdx.x; t < T0 + T1 + T2; t += gridDim.x) {
          f32x4 acc[4][4]; zero_acc(acc);
          int kind, mt, nt, K; const u16 *X, *W;
          if (t < T0) { kind = 0; tile_map(t, T0, 6, mt, nt); X = (const u16*)(ws + W_QBD); W = (const u16*)(ws + W_WQ); K = 384; }
          else if (t < T0 + T1) { kind = 1; tile_map(t - T0, T1, 8, mt, nt); X = (const u16*)(ws + W_KVBD); W = (const u16*)(ws + W_WKV); K = 256; }
          else { kind = 2; const int tt = t - T0 - T1; mt = tt >> 3; nt = tt & 7; X = (const u16*)(ws + W_CKVC); W = (const u16*)(ws + W_WKVC); K = 256; }
          gemm_core<false, false>(X, K, W, K, mt * 128, nt * 128, smem, acc);
          const WavePos w = wave_pos(mt * 128, nt * 128);
          if (kind < 2) {
            const float* sq = ssq + (kind ? MT : 0);
            const float rk = kind ? (1.f / 256.f) : (1.f / 384.f);
            const float qs = kind ? 1.f : QSC_B;
#pragma unroll
            for (int mi = 0; mi < 4; ++mi) {
              const float rs = rsqrtf(sq[w.mb + mi * 16 + w.fr] * rk + EPS) * qs;
#pragma unroll
              for (int ni = 0; ni < 4; ++ni) acc[ni][mi] *= rs;
            }
          }
          if (kind == 0) {
            if (w.mb >= MCTX && w.nb >= 512) rope32(w, acc, 4);
            store_all_tiled((u16*)(ws + W_QB), 768, w.nb, w, acc);
          } else if (w.nb < 512) {
            store_all((u16*)(ws + (kind == 1 ? W_KBN : W_KBNC)), 512, w.nb, w, acc);
          } else if (kind == 1) {
            store_vt((u16*)(ws + W_VBT), 8, (w.nb - 512) >> 6, w, acc);
          } else {
            u16* VT = (u16*)(ws + W_VBTC);
            const int head = (w.nb - 512) >> 6;
#pragma unroll
            for (int mi = 0; mi < 4; ++mi) {
              const int m = w.mb + mi * 16 + w.fr, b = m >> 9, s = m & 511;
              u16* bp = VT + ((size_t)(b * 8 + head) * 64) * 512 + s;
#pragma unroll
              for (int ni = 0; ni < 4; ++ni)
#pragma unroll
                for (int j = 0; j < 4; ++j) bp[(size_t)(ni * 16 + w.fq * 4 + j) * 512] = (u16)(pk2(acc[ni][mi][j], 0.f) & 0xffffu);
            }
          }
        }
        {
          const int lane = tidx() & 63, gw = blockIdx.x * 4 + (tidx() >> 6), nw = gridDim.x * 4;
          const float4 g = *(const float4*)(P.in[I_GKVA] + l * 256 + lane * 4);
          for (int m = gw; m < MCTX; m += nw) {
            const float rs = rsqrtf(ssq[MT + m] * (1.f / 256.f) + EPS);
            float4* p = (float4*)(P.out + O_NCKV + ((size_t)(((m >> 8) * 4 + l) * 256 + (m & 255))) * 256 + lane * 4);
            float4 v = *p;
            v.x *= rs * g.x; v.y *= rs * g.y; v.z *= rs * g.z; v.w *= rs * g.w;
            *p = v;
          }
        }
      } else if (sub == 2) {
#if PROBE_DUP == 2
        attn_phase(P, l, smem, true);
        xcd_barrier(bar, xb_x, xb_nloc, xb_nx);
#endif
        attn_phase(P, l, smem, false);
      } else if (sub == 3) {
        constexpr int T = 192 * 8;
        const u16* G = (const u16*)(ws + W_GATES);
        for (int t = blockIdx.x; t < T; t += gridDim.x) {
          int mt, nt; tile_map(t, T, 8, mt, nt);
          const WavePos w = wave_pos(mt * 128, nt * 128);
          f32x4 tot[4][4]; zero_acc(tot);
#pragma unroll 1
          for (int br = 0; br < 3; ++br) {
            f32x4 acc[4][4]; zero_acc(acc);
            const u16* A = br == 0 ? (const u16*)(ws + W_QA) : (br == 1 ? (const u16*)(ws + W_QB) : (const u16*)(ws + W_QC));
            gemm_core<true, true>(A, br == 1 ? 768 : 512, (const u16*)(ws + W_WO3) + (size_t)br * 1024 * 512, 512, mt * 128, nt * 128, smem, acc);
#pragma unroll
            for (int mi = 0; mi < 4; ++mi) {
              const u16* gp = G + (size_t)(w.mb + mi * 16 + w.fr) * 3072 + br * 1024 + w.nb + w.fq * 4;
#pragma unroll
              for (int ni = 0; ni < 4; ++ni) {
                const uint2 gb = *(const uint2*)(gp + ni * 16);
                tot[ni][mi][0] += bflo(gb.x) * acc[ni][mi][0]; tot[ni][mi][1] += bfhi(gb.x) * acc[ni][mi][1];
                tot[ni][mi][2] += bflo(gb.y) * acc[ni][mi][2]; tot[ni][mi][3] += bfhi(gb.y) * acc[ni][mi][3];
              }
            }
          }
          store_all_tiled((u16*)(ws + W_MBUF), 1024, w.nb, w, tot);
        }
      } else if (sub == 4) {
        constexpr int T = 192 * 8;
        for (int t = blockIdx.x; t < T; t += gridDim.x) {
          int mt, nt; tile_map(t, T, 8, mt, nt);
          f32x4 acc[4][4]; zero_acc(acc);
          gemm_core<true, true>((const u16*)(ws + W_MBUF), 1024, (const u16*)(ws + W_WOUT), 1024, mt * 128, nt * 128, smem, acc);
          const WavePos w = wave_pos(mt * 128, nt * 128);
          store_all((u16*)(ws + W_T), 1024, w.nb, w, acc);
        }
      } else if (sub == 5) {
        rows_phase(P, 1, l);
      } else if (sub == 6) {
        constexpr int T = 96 * 32;
#if PROBE_DUP == 6
        for (int rep = 0; rep < 2; ++rep) {
        if (rep) xcd_barrier(bar, xb_x, xb_nloc, xb_nx);
#endif
        gemm_phase_big<true, true>((const u16*)(ws + W_H), 1024, (const u16*)(ws + W_W1), 1024, T, 32, smem,
          [&](int m0, int n0, f32x4 (&acc)[2][4][4]) {
#pragma unroll
            for (int mh = 0; mh < 2; ++mh) {
              const WavePos w = wave_pos_big(m0, n0, mh);
#pragma unroll
              for (int ni = 0; ni < 4; ++ni)
#pragma unroll
                for (int mi = 0; mi < 4; ++mi)
#pragma unroll
                  for (int j = 0; j < 4; ++j) { const float v = fmaxf(acc[mh][ni][mi][j], 0.f); acc[mh][ni][mi][j] = v * v; }
              store_all_tiled((u16*)(ws + W_U), 4096, w.nb, w, acc[mh]);
            }
          });
#if PROBE_DUP == 6
        }
#endif
      } else if (sub == 7) {
        constexpr int T = 192 * 8;
        for (int t = blockIdx.x; t < T; t += gridDim.x) {
          int mt, nt; tile_map(t, T, 8, mt, nt);
          f32x4 acc[4][4]; zero_acc(acc);
          gemm_core<true, true>((const u16*)(ws + W_U), 4096, (const u16*)(ws + W_W2), 4096, mt * 128, nt * 128, smem, acc);
          const WavePos w = wave_pos(mt * 128, nt * 128);
          store_all((u16*)(ws + W_T), 1024, w.nb, w, acc);
        }
      } else {
        if (l + 1 < DEPTH)
          for (int it = blockIdx.x; it < CONV_ITEMS; it += gridDim.x) convert_item(P, l + 1, it, smem);
        rows_phase(P, 2, l);
      }
#if PROBE_SUB >= 0
      }
#endif
    }
#if MK_COOP
    if (ph + 1 < ph_hi) {
      if (ph_hi < 0) cg::this_grid().sync();
      xcd_barrier(bar, xb_x, xb_nloc, xb_nx);
    }
#endif
  }
}

extern "C" void kernel_launch(void* const* d_in, const int* in_sizes, int n_in, void* d_out, int out_size, void* d_ws, size_t ws_size,
                              hipStream_t stream) {
  static int grid = 0;
  if (grid == 0) {
    int dev = 0, cus = 0, per_cu = 0;
    hipGetDevice(&dev);
    hipDeviceGetAttribute(&cus, hipDeviceAttributeMultiprocessorCount, dev);
    hipFuncSetAttribute((const void*)fwd_kernel, hipFuncAttributeMaxDynamicSharedMemorySize, LDS_BYTES);
    hipOccupancyMaxActiveBlocksPerMultiprocessor(&per_cu, (const void*)fwd_kernel, 256, LDS_BYTES);
    if (per_cu < 1) per_cu = 1;
    if (per_cu > 2) per_cu = 2;
    grid = cus * per_cu;
    if (n_in != 30 || ws_size < W_END) { fprintf(stderr, "kernel_launch: unexpected n_in %d / ws_size %zu (need %zu)\n", n_in, ws_size, (size_t)W_END); }
  }
  Params p{};
  for (int i = 0; i < 30; ++i) p.in[i] = (const float*)d_in[i];
  p.out = (float*)d_out;
  p.ws = (unsigned char*)d_ws;
#if MK_COOP
  hipMemsetAsync((unsigned char*)d_ws + W_BAR, 0, XCD_BAR_WORDS * 4, stream);
  int lo = 0, hi = NPHASE;
  void* args[] = {&p, &lo, &hi};
  hipError_t e = hipLaunchCooperativeKernel((const void*)fwd_kernel, dim3(grid), dim3(256), args, LDS_BYTES, stream);
  if (e != hipSuccess) fprintf(stderr, "cooperative launch failed: %s (grid %d)\n", hipGetErrorString(e), grid);
#else
  for (int ph = 0; ph < NPHASE; ++ph) hipLaunchKernelGGL(fwd_kernel, dim3(grid), dim3(256), LDS_BYTES, stream, p, ph, ph + 1);
#endif
}
```

```cpp
#include <hip/hip_runtime.h>
#include <hip/hip_cooperative_groups.h>
#include <stdint.h>
#include <stdio.h>
namespace cg = cooperative_groups;

#ifndef PROBE_VAR
#define PROBE_VAR 0
#endif
#ifndef PROBE_SUB
#define PROBE_SUB -1
#endif
#if PROBE_SUB >= 0
#define PROBE_FIRST (prep == 0)
#else
#define PROBE_FIRST true
#endif
#ifndef PROBE_DUP
#define PROBE_DUP 0
#endif
#ifndef MK_COOP
#define MK_COOP 1
#endif

typedef unsigned short u16;
typedef __attribute__((ext_vector_type(8))) short bf16x8;
typedef __attribute__((ext_vector_type(4))) float f32x4;
typedef __attribute__((ext_vector_type(16))) float f32x16;
typedef __attribute__((ext_vector_type(2))) float f32x2_t;
typedef __attribute__((ext_vector_type(2))) __bf16 bf16x2_t;

constexpr int DM = 1024, MCTX = 8192, MLAT = 16384, MT = 24576, DEPTH = 4;
constexpr int NIN = 5280, NINP = 5376;
constexpr float EPS = 1e-6f;
constexpr float LOG2E = 1.4426950408889634f;
constexpr float L2THETA = 13.287712379549449f;
constexpr float QSC_AC = 0.125f * 1.4426950408889634f, QSC_B = 0.10206207261596575f * 1.4426950408889634f;

constexpr size_t O_NAK = 25165824, O_NAV = 29360128, O_NCKV = 33554432, O_NKR = 41943040, O_NCK = 42991616, O_NCV = 47185920;

constexpr size_t MiB = 1u << 20;
constexpr size_t W_WIN = 0, W_WQ = 11 * MiB, W_WKV = 12 * MiB, W_WKVC = 12 * MiB + 512 * 1024, W_WO3 = 13 * MiB, W_WOUT = 16 * MiB,
                 W_W1 = 18 * MiB, W_W2 = 26 * MiB;
constexpr size_t W_KCA = 34 * MiB, W_VCAT = 34 * MiB + 512 * 1024, W_KCC = 35 * MiB, W_VCCT = 35 * MiB + 512 * 1024, W_CKVC = 36 * MiB,
                 W_KRC = 37 * MiB, W_KBNC = 38 * MiB, W_VBTC = 40 * MiB;
constexpr size_t W_MOD = 42 * MiB, W_SSQ = 43 * MiB, W_BAR = 43 * MiB + 900 * 1024, W_H = 44 * MiB;
constexpr size_t R1 = 92 * MiB;
constexpr size_t W_QA = R1, W_KA = R1 + 24 * MiB, W_VAT = R1 + 30 * MiB, W_QBD = R1 + 36 * MiB, W_KVBD = R1 + 54 * MiB, W_QB = R1 + 66 * MiB,
                 W_KBN = R1 + 102 * MiB, W_VBT = R1 + 126 * MiB, W_KR = R1 + 150 * MiB, W_QC = R1 + 152 * MiB, W_KC = R1 + 176 * MiB,
                 W_VCT = R1 + 182 * MiB, W_GATES = R1 + 188 * MiB, W_END = R1 + 332 * MiB;
constexpr size_t W_T = R1 + 200 * MiB;
constexpr size_t W_U = R1;
constexpr size_t W_MBUF = W_KBN;

struct Params { const float* in[30]; float* out; unsigned char* ws; };
enum { I_XP = 0, I_XS, I_CAK, I_CAV, I_CCKV, I_CKR, I_CCK, I_CCV, I_C, I_CCTX, I_WMOD, I_BMOD, I_GPREMIX, I_GPOSTMIX, I_GPREMLP, I_GPOSTMLP,
       I_WIN, I_SINK, I_GQA, I_WQUP, I_GKVA, I_WKVUP, I_GQC, I_GKC, I_WOA, I_WOB, I_WOC, I_WOUT, I_W1, I_W2 };

__device__ __forceinline__ unsigned pk2(float lo, float hi) { f32x2_t v = {lo, hi}; bf16x2_t b = __builtin_convertvector(v, bf16x2_t); return __builtin_bit_cast(unsigned, b); }
__device__ __forceinline__ float bflo(unsigned u) { return __uint_as_float(u << 16); }
__device__ __forceinline__ float bfhi(unsigned u) { return __uint_as_float(u & 0xffff0000u); }
__device__ __forceinline__ float wave_sum(float v) {
#pragma unroll
  for (int o = 32; o >= 1; o >>= 1) v += __shfl_xor(v, o);
  return v;
}
__device__ __forceinline__ int tidx() { int t = threadIdx.x; asm volatile("" : "+v"(t)); return t; }
__device__ __forceinline__ uint4 ld16(const void* p) { return *(const uint4*)p; }
__device__ __forceinline__ void st4bf(u16* p, f32x4 v) { uint2 w; w.x = pk2(v[0], v[1]); w.y = pk2(v[2], v[3]); *(uint2*)p = w; }

__device__ __forceinline__ size_t tiled_off(int r, int k, int K) { return (size_t)(r & ~15) * K + (size_t)(k >> 5) * 512 + (r & 15) * 32 + (k & 31); }
__device__ __forceinline__ int perm_col(int type, int n) {
  if (type == 1) { if (n < 1408) return n; if (n < 1440) return 5248 + (n - 1408); return n - 32; }
  if (type == 2) { int h = n / 96, d = n - h * 96; return d < 64 ? h * 64 + d : 512 + h * 32 + (d - 64); }
  if (type == 3) { int h = n >> 7, d = n & 127; return d < 64 ? h * 64 + d : 512 + h * 64 + (d - 64); }
  return n;
}
__device__ __forceinline__ void conv_tile(const float* __restrict__ src, int K, int N, u16* __restrict__ dst, int k0, int n0, int type,
                                          const float* __restrict__ scale, char* smem, bool tiled = true) {
  float* T = (float*)smem;
  const int tid = tidx();
  {
    const int n = tid & 63, kr = tid >> 6;
#pragma unroll 4
    for (int i = 0; i < 16; ++i) {
      const int k = kr + 4 * i;
      float v = (n0 + n < N) ? src[(size_t)(k0 + k) * N + n0 + n] : 0.f;
      if (scale) v *= scale[k0 + k];
      T[k * 65 + n] = v;
    }
  }
  __syncthreads();
  {
    const int nl = tid >> 2, kc = (tid & 3) * 16, n = n0 + nl;
    if (n < N) {
      unsigned w[8];
#pragma unroll
      for (int j = 0; j < 8; ++j) w[j] = pk2(T[(kc + 2 * j) * 65 + nl], T[(kc + 2 * j + 1) * 65 + nl]);
      const int np = perm_col(type, n);
      u16* d = dst + (tiled ? tiled_off(np, k0 + kc, K) : (size_t)np * K + k0 + kc);
      *(uint4*)d = make_uint4(w[0], w[1], w[2], w[3]);
      *(uint4*)(d + 8) = make_uint4(w[4], w[5], w[6], w[7]);
    }
  }
  __syncthreads();
}

constexpr int CONV_ITEMS = 1328 + 72 + 64 + 64 + 384 + 256 + 1024 + 1024 + 800;

__device__ __forceinline__ void convert_item(const Params& P, int l, int it, char* smem) {
  unsigned char* ws = P.ws;
  const int tid = tidx();
  if (it < 1328) { conv_tile(P.in[I_WIN] + (size_t)l * 1024 * NIN, 1024, NIN, (u16*)(ws + W_WIN), (it & 15) * 64, (it >> 4) * 64, 1, nullptr, smem); return; }
  it -= 1328;
  if (it < 72) { conv_tile(P.in[I_WQUP] + (size_t)l * 384 * 768, 384, 768, (u16*)(ws + W_WQ), (it % 6) * 64, (it / 6) * 64, 2, P.in[I_GQA] + l * 384, smem, false); return; }
  it -= 72;
  if (it < 64) { conv_tile(P.in[I_WKVUP] + (size_t)l * 256 * 1024, 256, 1024, (u16*)(ws + W_WKV), (it & 3) * 64, (it >> 2) * 64, 3, P.in[I_GKVA] + l * 256, smem, false); return; }
  it -= 64;
  if (it < 64) { conv_tile(P.in[I_WKVUP] + (size_t)l * 256 * 1024, 256, 1024, (u16*)(ws + W_WKVC), (it & 3) * 64, (it >> 2) * 64, 3, nullptr, smem, false); return; }
  it -= 64;
  if (it < 384) {
    const int br = it >> 7, t = it & 127;
    const float *pa = P.in[I_WOA], *pb = P.in[I_WOB], *pc = P.in[I_WOC];
    asm volatile("" : "+s"(pa), "+s"(pb), "+s"(pc));
    conv_tile((br == 0 ? pa : (br == 1 ? pb : pc)) + (size_t)l * 512 * 1024, 512, 1024, (u16*)(ws + W_WO3) + (size_t)br * 1024 * 512, (t & 7) * 64, (t >> 3) * 64, 0, nullptr, smem);
    return;
  }
  it -= 384;
  if (it < 256) { conv_tile(P.in[I_WOUT] + (size_t)l * 1024 * 1024, 1024, 1024, (u16*)(ws + W_WOUT), (it & 15) * 64, (it >> 4) * 64, 0, nullptr, smem); return; }
  it -= 256;
  if (it < 1024) { conv_tile(P.in[I_W1] + (size_t)l * 1024 * 4096, 1024, 4096, (u16*)(ws + W_W1), (it & 15) * 64, (it >> 4) * 64, 0, nullptr, smem); return; }
  it -= 1024;
  if (it < 1024) { conv_tile(P.in[I_W2] + (size_t)l * 4096 * 1024, 4096, 1024, (u16*)(ws + W_W2), (it & 63) * 64, (it >> 6) * 64, 0, nullptr, smem); return; }
  it -= 1024;
  if (it < 512) {
    const float* src; u16* dst; int ncol, sh;
    const float *pa = P.in[I_CAK], *pb = P.in[I_CCK], *pc = P.in[I_CCKV];
    asm volatile("" : "+s"(pa), "+s"(pb), "+s"(pc));
    if (it < 128) { src = pa; dst = (u16*)(ws + W_KCA); ncol = 128; sh = 7; }
    else if (it < 256) { it -= 128; src = pb; dst = (u16*)(ws + W_KCC); ncol = 128; sh = 7; }
    else { it -= 256; src = pc; dst = (u16*)(ws + W_CKVC); ncol = 256; sh = 8; }
    const int e = (it * 256 + tid) * 8, row = e >> sh, c = e & (ncol - 1), b = row >> 9, s = row & 511;
    const float* sp = src + ((size_t)((b * 4 + l) * 512 + s)) * ncol + c;
    const float4 a = *(const float4*)sp, bb = *(const float4*)(sp + 4);
    *(uint4*)(dst + e) = make_uint4(pk2(a.x, a.y), pk2(a.z, a.w), pk2(bb.x, bb.y), pk2(bb.z, bb.w));
    return;
  }
  it -= 512;
  if (it < 32) {
    const int e = (it * 256 + tid) * 8, row = e >> 5, c = e & 31, b = row >> 9, s = row & 511;
    const float* sp = P.in[I_CKR] + ((size_t)((b * 4 + l) * 512 + s)) * 32 + c;
    const float4 a = *(const float4*)sp, bb = *(const float4*)(sp + 4);
    *(uint4*)((u16*)(ws + W_KRC) + e) = make_uint4(pk2(a.x, a.y), pk2(a.z, a.w), pk2(bb.x, bb.y), pk2(bb.z, bb.w));
    return;
  }
  it -= 32;
  {
    const float *pa = P.in[I_CAV], *pb = P.in[I_CCV];
    asm volatile("" : "+s"(pa), "+s"(pb));
    const float* src = pa; u16* dst = (u16*)(ws + W_VCAT);
    if (it >= 128) { it -= 128; src = pb; dst = (u16*)(ws + W_VCCT); }
    const int idx = it * 256 + tid, d = idx & 63, g = (idx >> 6) & 1, b = (idx >> 7) & 3, s8 = idx >> 9;
    const float* sp = src + ((size_t)((b * 4 + l) * 512 + s8 * 8)) * 128 + g * 64 + d;
    float v[8];
#pragma unroll
    for (int j = 0; j < 8; ++j) v[j] = sp[(size_t)j * 128];
    *(uint4*)(dst + ((size_t)((b * 2 + g) * 64 + d)) * 512 + s8 * 8) = make_uint4(pk2(v[0], v[1]), pk2(v[2], v[3]), pk2(v[4], v[5]), pk2(v[6], v[7]));
  }
}

__device__ __forceinline__ void mod_item(const Params& P, int it, char* smem) {
  float* sv = (float*)smem;
  float* red = (float*)(smem + 20480);
  const int tid = tidx(), l = it / 96, n0 = (it % 96) * 64;
  for (int e = tid; e < 5120; e += 256) {
    const int v = e >> 10, k = e & 1023;
    const float c = (v == 0) ? P.in[I_CCTX][k] : P.in[I_C][(v - 1) * 1024 + k];
    sv[e] = c / (1.f + __expf(-c));
  }
  __syncthreads();
  const int kq = tid >> 4, n4 = tid & 15;
  float acc[5][4];
#pragma unroll
  for (int v = 0; v < 5; ++v)
#pragma unroll
    for (int j = 0; j < 4; ++j) acc[v][j] = 0.f;
  const float* wp = P.in[I_WMOD] + ((size_t)l * 1024 + kq * 64) * 6144 + n0 + n4 * 4;
#pragma unroll 8
  for (int k = 0; k < 64; ++k) {
    const float4 w = *(const float4*)(wp + (size_t)k * 6144);
#pragma unroll
    for (int v = 0; v < 5; ++v) {
      const float s = sv[v * 1024 + kq * 64 + k];
      acc[v][0] += s * w.x; acc[v][1] += s * w.y; acc[v][2] += s * w.z; acc[v][3] += s * w.w;
    }
  }
#pragma unroll
  for (int v = 0; v < 5; ++v)
#pragma unroll
    for (int j = 0; j < 4; ++j) red[(kq * 5 + v) * 64 + n4 * 4 + j] = acc[v][j];
  __syncthreads();
  float* mod = (float*)(P.ws + W_MOD);
  for (int e = tid; e < 320; e += 256) {
    const int v = e >> 6, n = e & 63;
    float s = P.in[I_BMOD][l * 6144 + n0 + n];
#pragma unroll
    for (int q = 0; q < 16; ++q) s += red[(q * 5 + v) * 64 + n];
    mod[((size_t)l * 5 + v) * 6144 + n0 + n] = s;
  }
  __syncthreads();
}

__device__ __forceinline__ void rows_phase(const Params& P, int mode, int l) {
  const int lane = tidx() & 63, wid = tidx() >> 6;
  const int gw = blockIdx.x * 4 + wid, nw = gridDim.x * 4;
  const float* mod = (const float*)(P.ws + W_MOD);
  u16* H = (u16*)(P.ws + W_H);
  const u16* TB = (const u16*)(P.ws + W_T);
  const bool write_h = !(mode == 2 && l == DEPTH - 1);
  const int lh = (mode == 2) ? l + 1 : l;
  const float* gpost = (mode == 1) ? P.in[I_GPOSTMIX] + l * 1024 : P.in[I_GPOSTMLP] + l * 1024;
  const float* gpre = (mode == 1) ? P.in[I_GPREMLP] + l * 1024 : P.in[I_GPREMIX] + (write_h ? lh : 0) * 1024;
  for (int row = gw; row < MT; row += nw) {
    const int v = row < MCTX ? 0 : 1 + ((row - MCTX) >> 12);
    float* xp = P.out + (size_t)row * 1024;
    float x[16];
    if (mode == 0) {
      const float* src = row < MCTX ? P.in[I_XP] + (size_t)row * 1024 : P.in[I_XS] + (size_t)(row - MCTX) * 1024;
#pragma unroll
      for (int i = 0; i < 4; ++i) { const float4 a = *(const float4*)(src + i * 256 + lane * 4); x[4 * i] = a.x; x[4 * i + 1] = a.y; x[4 * i + 2] = a.z; x[4 * i + 3] = a.w; }
    } else {
      float t[16];
      float ss = 0.f;
#pragma unroll
      for (int i = 0; i < 4; ++i) {
        const f32x4 av = __builtin_nontemporal_load((const f32x4*)(xp + i * 256 + lane * 4));
        const float4 a = make_float4(av[0], av[1], av[2], av[3]);
        x[4 * i] = a.x; x[4 * i + 1] = a.y; x[4 * i + 2] = a.z; x[4 * i + 3] = a.w;
        const uint2 tb = *(const uint2*)(TB + (size_t)row * 1024 + i * 256 + lane * 4);
        t[4 * i] = bflo(tb.x); t[4 * i + 1] = bfhi(tb.x); t[4 * i + 2] = bflo(tb.y); t[4 * i + 3] = bfhi(tb.y);
      }
#pragma unroll
      for (int i = 0; i < 16; ++i) ss += t[i] * t[i];
      ss = wave_sum(ss);
      const float rstd = rsqrtf(ss * (1.f / 1024.f) + EPS);
      const float* gate = mod + ((size_t)l * 5 + v) * 6144 + (mode == 1 ? 2048 : 5120);
#pragma unroll
      for (int i = 0; i < 4; ++i) {
        const float4 gt = *(const float4*)(gate + i * 256 + lane * 4);
        const float4 gp = *(const float4*)(gpost + i * 256 + lane * 4);
        x[4 * i] += gt.x * (t[4 * i] * rstd * gp.x);
        x[4 * i + 1] += gt.y * (t[4 * i + 1] * rstd * gp.y);
        x[4 * i + 2] += gt.z * (t[4 * i + 2] * rstd * gp.z);
        x[4 * i + 3] += gt.w * (t[4 * i + 3] * rstd * gp.w);
      }
    }
#pragma unroll
    for (int i = 0; i < 4; ++i) __builtin_nontemporal_store((f32x4){x[4 * i], x[4 * i + 1], x[4 * i + 2], x[4 * i + 3]}, (f32x4*)(xp + i * 256 + lane * 4));
    if (write_h) {
      float ss = 0.f;
#pragma unroll
      for (int i = 0; i < 16; ++i) ss += x[i] * x[i];
      ss = wave_sum(ss);
      const float rstd = rsqrtf(ss * (1.f / 1024.f) + EPS);
      const float* mb = mod + ((size_t)lh * 5 + v) * 6144;
      const float* shp = mb + (mode == 1 ? 3072 : 0);
      const float* scp = mb + (mode == 1 ? 4096 : 1024);
#pragma unroll
      for (int i = 0; i < 4; ++i) {
        const float4 g = *(const float4*)(gpre + i * 256 + lane * 4);
        const float4 sc = *(const float4*)(scp + i * 256 + lane * 4);
        const float4 sh = *(const float4*)(shp + i * 256 + lane * 4);
        const float h0 = x[4 * i] * rstd * g.x * (1.f + sc.x) + sh.x;
        const float h1 = x[4 * i + 1] * rstd * g.y * (1.f + sc.y) + sh.y;
        const float h2 = x[4 * i + 2] * rstd * g.z * (1.f + sc.z) + sh.z;
        const float h3 = x[4 * i + 3] * rstd * g.w * (1.f + sc.w) + sh.w;
        uint2 w; w.x = pk2(h0, h1); w.y = pk2(h2, h3);
        *(uint2*)(H + tiled_off(row, i * 256 + lane * 4, 1024)) = w;
      }
    }
  }
}

#define LDS_PTR(p) ((__attribute__((address_space(3))) void*)(p))
__device__ __forceinline__ int swz4(int q) { return ((q & 1) << 1) | ((q >> 1) ^ (q & 1)); }
template <bool XT, bool WT>
__device__ __forceinline__ void gemm_core(const u16* __restrict__ X, int ldx, const u16* __restrict__ W, int K, int m0, int n0, char* smem,
                                          f32x4 (&acc)[4][4]) {
  const int tid = tidx(), lane = tid & 63, wid = tid >> 6;
  const int wn = wid >> 1, wm = wid & 1, fr = lane & 15, fq = lane >> 4;
  const int drow = wid * 16 + (lane >> 2);
  const int dch = (lane & 3) ^ swz4((lane >> 4) & 3);
  const u16* wg = W + (WT ? (size_t)(n0 + wid * 16) * K + (lane >> 2) * 32 : (size_t)(n0 + drow) * K) + dch * 8;
  const u16* xg = X + (XT ? (size_t)(m0 + wid * 16) * ldx + (lane >> 2) * 32 : (size_t)(m0 + drow) * ldx) + dch * 8;
  constexpr int KW = WT ? 512 : 32, KX = XT ? 512 : 32;
  const size_t wstep = (size_t)64 * K, xstep = (size_t)64 * ldx;
  char* dl = smem + wid * 1024 + lane * 16;
  auto issue = [&](int kt) {
    char* d = dl + (kt & 3) * 16384;
    const int kw = kt * KW, kx = kt * KX;
    __builtin_amdgcn_global_load_lds(wg + kw, LDS_PTR(d), 16, 0, 0);
    __builtin_amdgcn_global_load_lds(wg + wstep + kw, LDS_PTR(d + 4096), 16, 0, 0);
    __builtin_amdgcn_global_load_lds(xg + kx, LDS_PTR(d + 8192), 16, 0, 0);
    __builtin_amdgcn_global_load_lds(xg + xstep + kx, LDS_PTR(d + 8192 + 4096), 16, 0, 0);
  };
  const int nk = K >> 5;
  asm volatile("s_waitcnt vmcnt(0)" ::: "memory");
  __builtin_amdgcn_s_barrier();
  issue(0); issue(1); issue(2);
  const int co = (fq ^ swz4((fr >> 2) & 3)) << 4;
  const int aoff = (wn * 64 + fr) * 64 + co, boff = 8192 + (wm * 64 + fr) * 64 + co;
  bf16x8 a0[4], b0[4], a1[4], b1[4];
  asm volatile("s_waitcnt vmcnt(8)" ::: "memory");
  __builtin_amdgcn_s_barrier();
  asm volatile("" ::: "memory");
  issue(3);
#pragma unroll
  for (int i = 0; i < 4; ++i) { a0[i] = *(const bf16x8*)(smem + aoff + i * 1024); b0[i] = *(const bf16x8*)(smem + boff + i * 1024); }
#define GEMM_STEP(kt, AC, BC, AN, BN) do { \
    if ((kt) + 1 < nk) { \
      if ((kt) + 3 < nk) asm volatile("s_waitcnt vmcnt(8) lgkmcnt(0)" ::: "memory"); \
      else if ((kt) + 2 < nk) asm volatile("s_waitcnt vmcnt(4) lgkmcnt(0)" ::: "memory"); \
      else asm volatile("s_waitcnt vmcnt(0) lgkmcnt(0)" ::: "memory"); \
      __builtin_amdgcn_s_barrier(); \
      asm volatile("" ::: "memory"); \
      if ((kt) + 4 < nk) issue((kt) + 4); \
      const char* st_ = smem + (((kt) + 1) & 3) * 16384; \
      _Pragma("unroll") for (int i = 0; i < 4; ++i) { AN[i] = *(const bf16x8*)(st_ + aoff + i * 1024); BN[i] = *(const bf16x8*)(st_ + boff + i * 1024); } \
    } \
    _Pragma("unroll") for (int ni = 0; ni < 4; ++ni) \
      _Pragma("unroll") for (int mi = 0; mi < 4; ++mi) acc[ni][mi] = __builtin_amdgcn_mfma_f32_16x16x32_bf16(AC[ni], BC[mi], acc[ni][mi], 0, 0, 0); \
  } while (0)
  for (int kt = 0; kt < nk; kt += 2) {
    GEMM_STEP(kt, a0, b0, a1, b1);
    GEMM_STEP(kt + 1, a1, b1, a0, b0);
  }
#undef GEMM_STEP
}
__device__ __forceinline__ void tile_map_big(int t, int T, int ntn, int& mt, int& nt);
template <bool XT, bool WT, class Epi>
__device__ __forceinline__ void gemm_phase_big(const u16* __restrict__ X, int ldx, const u16* __restrict__ W, int K, int T, int ntn, char* smem, Epi epi) {
  int t = blockIdx.x;
  if (t >= T) return;
  const int tid = tidx(), lane = tid & 63, wid = tid >> 6;
  const int wn = wid >> 1, wm = wid & 1, fr = lane & 15, fq = lane >> 4;
  const int drow = wid * 16 + (lane >> 2);
  const int dch = (lane & 3) ^ swz4((lane >> 4) & 3);
  constexpr int KW = WT ? 512 : 32, KX = XT ? 512 : 32;
  const size_t woff = (WT ? (size_t)(wid * 16) * K + (lane >> 2) * 32 : (size_t)drow * K) + dch * 8;
  const size_t xoff = (XT ? (size_t)(wid * 16) * ldx + (lane >> 2) * 32 : (size_t)drow * ldx) + dch * 8;
  const size_t wstep = (size_t)64 * K, xstep = (size_t)64 * ldx;
  char* dl = smem + wid * 1024 + lane * 16;
  const u16 *wg, *xg;
  int rb = 0;
  auto issue = [&](int kt) {
    char* d = dl + ((rb + kt) % 3) * 24576;
    const int kw = kt * KW, kx = kt * KX;
    __builtin_amdgcn_global_load_lds(wg + kw, LDS_PTR(d), 16, 0, 0);
    __builtin_amdgcn_global_load_lds(wg + wstep + kw, LDS_PTR(d + 4096), 16, 0, 0);
    __builtin_amdgcn_global_load_lds(xg + kx, LDS_PTR(d + 8192), 16, 0, 0);
    __builtin_amdgcn_global_load_lds(xg + xstep + kx, LDS_PTR(d + 8192 + 4096), 16, 0, 0);
    __builtin_amdgcn_global_load_lds(xg + 2 * xstep + kx, LDS_PTR(d + 8192 + 8192), 16, 0, 0);
    __builtin_amdgcn_global_load_lds(xg + 3 * xstep + kx, LDS_PTR(d + 8192 + 12288), 16, 0, 0);
  };
  const int nk = K >> 5;
  const int co = (fq ^ swz4((fr >> 2) & 3)) << 4;
  const int aoff = (wn * 64 + fr) * 64 + co, boff = 8192 + (wm * 128 + fr) * 64 + co;
  int mt, nt;
  tile_map_big(t, T, ntn, mt, nt);
  wg = W + (size_t)(nt * 128) * K + woff;
  xg = X + (size_t)(mt * 256) * ldx + xoff;
  asm volatile("s_waitcnt vmcnt(0)" ::: "memory");
  __builtin_amdgcn_s_barrier();
  issue(0); issue(1);
  for (;;) {
    f32x4 acc[2][4][4];
#pragma unroll
    for (int mh = 0; mh < 2; ++mh)
#pragma unroll
      for (int i = 0; i < 4; ++i)
#pragma unroll
        for (int j = 0; j < 4; ++j) acc[mh][i][j] = (f32x4){0.f, 0.f, 0.f, 0.f};
    for (int kt = 0; kt < nk; ++kt) {
      if (kt + 1 < nk) asm volatile("s_waitcnt vmcnt(6)" ::: "memory");
      else asm volatile("s_waitcnt vmcnt(0)" ::: "memory");
      __builtin_amdgcn_s_barrier();
      asm volatile("" ::: "memory");
      if (kt + 2 < nk) issue(kt + 2);
      const char* st = smem + ((rb + kt) % 3) * 24576;
      bf16x8 a[4], b[8];
#pragma unroll
      for (int i = 0; i < 4; ++i) a[i] = *(const bf16x8*)(st + aoff + i * 1024);
#pragma unroll
      for (int i = 0; i < 8; ++i) b[i] = *(const bf16x8*)(st + boff + i * 1024);
#pragma unroll
      for (int mh = 0; mh < 2; ++mh)
#pragma unroll
        for (int ni = 0; ni < 4; ++ni)
#pragma unroll
          for (int mi = 0; mi < 4; ++mi) acc[mh][ni][mi] = __builtin_amdgcn_mfma_f32_16x16x32_bf16(a[ni], b[mh * 4 + mi], acc[mh][ni][mi], 0, 0, 0);
    }
    rb = (rb + nk) % 3;
    const int m0 = mt * 256, n0 = nt * 128;
    const int tn = t + gridDim.x;
    if (tn < T) {
      tile_map_big(tn, T, ntn, mt, nt);
      wg = W + (size_t)(nt * 128) * K + woff;
      xg = X + (size_t)(mt * 256) * ldx + xoff;
      issue(0); issue(1);
    }
    epi(m0, n0, acc);
    if (tn >= T) break;
    t = tn;
  }
}
__device__ __forceinline__ void tile_map_big(int t, int T, int ntn, int& mt, int& nt) {
  const int tp = (t & 7) * (T >> 3) + (t >> 3);
  const int g = 4 * ntn, ms = tp / g, rem = tp - ms * g;
  nt = rem >> 2; mt = ms * 4 + (rem & 3);
}
__device__ __forceinline__ void zero_acc(f32x4 (&acc)[4][4]) {
#pragma unroll
  for (int i = 0; i < 4; ++i)
#pragma unroll
    for (int j = 0; j < 4; ++j) acc[i][j] = (f32x4){0.f, 0.f, 0.f, 0.f};
}
__device__ __forceinline__ void tile_map(int t, int T, int ntn, int& mt, int& nt) {
  const int tp = (t & 7) * (T >> 3) + (t >> 3);
  const int g = 8 * ntn, ms = tp / g, rem = tp - ms * g;
  nt = rem >> 3; mt = ms * 8 + (rem & 7);
}

struct WavePos { int nb, mb, fr, fq; };
__device__ __forceinline__ WavePos wave_pos(int m0, int n0) {
  const int lane = tidx() & 63, wid = tidx() >> 6;
  WavePos w; w.nb = n0 + (wid >> 1) * 64; w.mb = m0 + (wid & 1) * 64; w.fr = lane & 15; w.fq = lane >> 4; return w;
}
__device__ __forceinline__ WavePos wave_pos_big(int m0, int n0, int mh) {
  const int lane = tidx() & 63, wid = tidx() >> 6;
  WavePos w; w.nb = n0 + (wid >> 1) * 64; w.mb = m0 + (wid & 1) * 128 + mh * 64; w.fr = lane & 15; w.fq = lane >> 4; return w;
}

__device__ __forceinline__ void store_all(u16* C, int ldc, int c0, const WavePos& w, f32x4 (&acc)[4][4]) {
#pragma unroll
  for (int mi = 0; mi < 4; ++mi) {
    u16* rp = C + (size_t)(w.mb + mi * 16 + w.fr) * ldc + c0 + w.fq * 4;
#pragma unroll
    for (int ni = 0; ni < 4; ++ni) st4bf(rp + ni * 16, acc[ni][mi]);
  }
}
__device__ __forceinline__ void store_all_tiled(u16* C, int K, int c0, const WavePos& w, f32x4 (&acc)[4][4]) {
#pragma unroll
  for (int mi = 0; mi < 4; ++mi) {
    const int m = w.mb + mi * 16 + w.fr;
#pragma unroll
    for (int ni = 0; ni < 4; ++ni) st4bf(C + tiled_off(m, c0 + ni * 16 + w.fq * 4, K), acc[ni][mi]);
  }
}
__device__ __forceinline__ void store_ctx_f32(float* outb, int ncols, int c0, int l, const WavePos& w, f32x4 (&acc)[4][4], int nimax) {
#pragma unroll
  for (int mi = 0; mi < 4; ++mi) {
    const int m = w.mb + mi * 16 + w.fr, b = m >> 8, s = m & 255;
    float* rp = outb + ((size_t)((b * 4 + l) * 256 + s)) * ncols + c0 + w.fq * 4;
#pragma unroll
    for (int ni = 0; ni < 4; ++ni) if (ni < nimax) *(float4*)(rp + ni * 16) = make_float4(acc[ni][mi][0], acc[ni][mi][1], acc[ni][mi][2], acc[ni][mi][3]);
  }
}
__device__ __forceinline__ void store_vt(u16* VT, int NH, int head, const WavePos& w, f32x4 (&acc)[4][4]) {
#pragma unroll
  for (int mi = 0; mi < 4; ++mi) {
    const int m = w.mb + mi * 16 + w.fr;
    u16* bp; size_t stride;
    if (m < MCTX) { const int b = m >> 8, s = m & 255; bp = VT + ((size_t)(b * NH + head) * 64) * 256 + s; stride = 256; }
    else { const int ml = m - MCTX, b = ml >> 12, t = ml & 4095; bp = VT + (size_t)MCTX * NH * 64 + ((size_t)(b * NH + head) * 64) * 4096 + t; stride = 4096; }
#pragma unroll
    for (int ni = 0; ni < 4; ++ni)
#pragma unroll
      for (int j = 0; j < 4; ++j) {
        const int d = ni * 16 + w.fq * 4 + j;
        bp[(size_t)d * stride] = (u16)(pk2(acc[ni][mi][j], 0.f) & 0xffffu);
      }
  }
}
__device__ __forceinline__ void rope64(const WavePos& w, f32x4 (&acc)[4][4]) {
  float inv[4];
#pragma unroll
  for (int j = 0; j < 4; ++j) inv[j] = exp2f(-(float)(w.fq * 4 + j) * (L2THETA / 16.f));
#pragma unroll
  for (int mi = 0; mi < 4; ++mi) {
    const int t = (w.mb + mi * 16 + w.fr - MCTX) & 4095;
    const float pr = (float)(t >> 6), pc = (float)(t & 63);
#pragma unroll
    for (int hf = 0; hf < 2; ++hf) {
      const float pos = hf ? pc : pr;
#pragma unroll
      for (int j = 0; j < 4; ++j) {
        const float a = pos * inv[j], sn = __sinf(a), cs = __cosf(a);
        const float x1 = acc[2 * hf][mi][j], x2 = acc[2 * hf + 1][mi][j];
        acc[2 * hf][mi][j] = x1 * cs - x2 * sn;
        acc[2 * hf + 1][mi][j] = x2 * cs + x1 * sn;
      }
    }
  }
}
__device__ __forceinline__ void rope32(const WavePos& w, f32x4 (&acc)[4][4], int nimax) {
  float inv[4];
#pragma unroll
  for (int j = 0; j < 4; ++j) inv[j] = exp2f(-(float)((w.fq & 1) * 4 + j) * (L2THETA / 8.f));
  const bool second = w.fq >= 2;
#pragma unroll
  for (int mi = 0; mi < 4; ++mi) {
    const int t = (w.mb + mi * 16 + w.fr - MCTX) & 4095;
    const float pr = (float)(t >> 6), pc = (float)(t & 63);
#pragma unroll
    for (int ni = 0; ni < 4; ++ni) {
      if (ni < nimax) {
        const float pos = (ni & 1) ? pc : pr;
#pragma unroll
        for (int j = 0; j < 4; ++j) {
          const float a = pos * inv[j], sn = __sinf(a), cs = __cosf(a);
          const float x = acc[ni][mi][j], o = __shfl_xor(x, 32);
          acc[ni][mi][j] = second ? (x * cs + o * sn) : (x * cs - o * sn);
        }
      }
    }
  }
}
__device__ __forceinline__ void row_ssq(f32x4 (&acc)[4][4], float (&ss)[4]) {
#pragma unroll
  for (int mi = 0; mi < 4; ++mi) {
    float s = 0.f;
#pragma unroll
    for (int ni = 0; ni < 4; ++ni)
#pragma unroll
      for (int j = 0; j < 4; ++j) s += acc[ni][mi][j] * acc[ni][mi][j];
    s += __shfl_xor(s, 16);
    s += __shfl_xor(s, 32);
    ss[mi] = s;
  }
}
__device__ __forceinline__ void head_norm(const WavePos& w, f32x4 (&acc)[4][4], const float* g) {
  float ss[4];
  row_ssq(acc, ss);
#pragma unroll
  for (int ni = 0; ni < 4; ++ni) {
    const float4 gv = *(const float4*)(g + ni * 16 + w.fq * 4);
#pragma unroll
    for (int mi = 0; mi < 4; ++mi) {
      const float r = rsqrtf(ss[mi] * (1.f / 64.f) + EPS);
      acc[ni][mi][0] *= r * gv.x; acc[ni][mi][1] *= r * gv.y; acc[ni][mi][2] *= r * gv.z; acc[ni][mi][3] *= r * gv.w;
    }
  }
}
__device__ __forceinline__ void ssq_atomic(const WavePos& w, f32x4 (&acc)[4][4], float* ssq) {
  float ss[4];
  row_ssq(acc, ss);
  if (w.fq == 0) {
#pragma unroll
    for (int mi = 0; mi < 4; ++mi) atomicAdd(ssq + w.mb + mi * 16 + w.fr, ss[mi]);
  }
}

__device__ __forceinline__ void scale_acc(f32x4 (&acc)[4][4], float f) {
#pragma unroll
  for (int ni = 0; ni < 4; ++ni)
#pragma unroll
    for (int mi = 0; mi < 4; ++mi) acc[ni][mi] *= f;
}
__device__ __forceinline__ void epi_win(const Params& P, int l, const WavePos& w, f32x4 (&acc)[4][4], bool do_atomic = true) {
  unsigned char* ws = P.ws;
  const bool lat = w.mb >= MCTX;
  const int nb = w.nb;
  float* ssq = (float*)(ws + W_SSQ) + (size_t)l * 2 * MT;
  if (nb < 512) { if (lat) rope64(w, acc); scale_acc(acc, QSC_AC); store_all_tiled((u16*)(ws + W_QA), 512, nb, w, acc); }
  else if (nb < 640) {
    if (!lat) store_ctx_f32(P.out + O_NAK, 128, nb - 512, l, w, acc, 4); else rope64(w, acc);
    store_all((u16*)(ws + W_KA), 128, nb - 512, w, acc);
  } else if (nb < 768) {
    if (!lat) store_ctx_f32(P.out + O_NAV, 128, nb - 640, l, w, acc, 4);
    store_vt((u16*)(ws + W_VAT), 2, (nb - 640) >> 6, w, acc);
  } else if (nb < 1152) { store_all((u16*)(ws + W_QBD), 384, nb - 768, w, acc); if (do_atomic) ssq_atomic(w, acc, ssq); }
  else if (nb < 1408) {
    store_all((u16*)(ws + W_KVBD), 256, nb - 1152, w, acc); if (do_atomic) ssq_atomic(w, acc, ssq + MT);
    if (!lat) store_ctx_f32(P.out + O_NCKV, 256, nb - 1152, l, w, acc, 4);
  } else if (nb < 1920) { head_norm(w, acc, P.in[I_GQC] + l * 64); if (lat) rope64(w, acc); scale_acc(acc, QSC_AC); store_all_tiled((u16*)(ws + W_QC), 512, nb - 1408, w, acc); }
  else if (nb < 2048) {
    head_norm(w, acc, P.in[I_GKC] + l * 64);
    if (!lat) store_ctx_f32(P.out + O_NCK, 128, nb - 1920, l, w, acc, 4); else rope64(w, acc);
    store_all((u16*)(ws + W_KC), 128, nb - 1920, w, acc);
  } else if (nb < 2176) {
    if (!lat) store_ctx_f32(P.out + O_NCV, 128, nb - 2048, l, w, acc, 4);
    store_vt((u16*)(ws + W_VCT), 2, (nb - 2048) >> 6, w, acc);
  } else if (nb < 5248) {
#pragma unroll
    for (int ni = 0; ni < 4; ++ni)
#pragma unroll
      for (int mi = 0; mi < 4; ++mi)
#pragma unroll
        for (int j = 0; j < 4; ++j) acc[ni][mi][j] = __builtin_amdgcn_rcpf(1.f + __builtin_amdgcn_exp2f(-LOG2E * acc[ni][mi][j]));
    store_all((u16*)(ws + W_GATES), 3072, nb - 2176, w, acc);
  } else if (nb == 5248) {
    if (!lat) store_ctx_f32(P.out + O_NKR, 32, 0, l, w, acc, 2); else rope32(w, acc, 2);
    u16* KR = (u16*)(ws + W_KR);
#pragma unroll
    for (int mi = 0; mi < 4; ++mi) {
      u16* rp = KR + (size_t)(w.mb + mi * 16 + w.fr) * 32 + w.fq * 4;
      st4bf(rp, acc[0][mi]); st4bf(rp + 16, acc[1][mi]);
    }
  }
}


template <int MIX>
__device__ __forceinline__ void attn_unit(const Params& P, int l, bool lat, int b, int h, int qb, char* smem, bool dummy) {
  unsigned char* ws = P.ws;
  const int tid = tidx(), lane = tid & 63, wv = tid >> 6, r = lane & 31, hh = lane >> 5;
  constexpr int NS = (MIX == 1) ? 6 : 4;
  const int g = h >> 2;
  const int rq0 = lat ? MCTX + b * 4096 + qb * 128 : b * 256 + qb * 128;
  const int qrow = rq0 + wv * 32 + r;
  u16* qbase; int qld;
  if (MIX == 0) { qbase = (u16*)(ws + W_QA); qld = 512; } else if (MIX == 1) { qbase = (u16*)(ws + W_QB); qld = 768; } else { qbase = (u16*)(ws + W_QC); qld = 512; }
  bf16x8 qf[NS];
  {
#pragma unroll
    for (int s = 0; s < 4; ++s) qf[s] = *(const bf16x8*)(qbase + tiled_off(qrow, h * 64 + s * 16 + hh * 8, qld));
    if (MIX == 1) {
#pragma unroll
      for (int s = 4; s < NS; ++s) qf[s] = *(const bf16x8*)(qbase + tiled_off(qrow, 512 + h * 32 + (s - 4) * 16 + hh * 8, qld));
    }
  }
  constexpr int KST = (MIX == 1) ? 512 : 128;
  const u16 *K0, *K1, *R0 = nullptr, *R1p = nullptr, *V0, *V1;
  int vs0, vs1, nt0, nt1, pos1 = 0;
  if (!lat) {
    const int r0 = b * 256;
    if (MIX == 0) { K0 = (const u16*)(ws + W_KA) + (size_t)r0 * 128 + g * 64; V0 = (const u16*)(ws + W_VAT) + ((size_t)(b * 2 + g) * 64) * 256; }
    else if (MIX == 1) { K0 = (const u16*)(ws + W_KBN) + (size_t)r0 * 512 + h * 64; R0 = (const u16*)(ws + W_KR) + (size_t)r0 * 32; V0 = (const u16*)(ws + W_VBT) + ((size_t)(b * 8 + h) * 64) * 256; }
    else { K0 = (const u16*)(ws + W_KC) + (size_t)r0 * 128 + g * 64; V0 = (const u16*)(ws + W_VCT) + ((size_t)(b * 2 + g) * 64) * 256; }
    vs0 = 256; nt0 = 4;
    K1 = K0; R1p = R0; V1 = V0; vs1 = 256; nt1 = 0;
  } else {
    const int c0 = b * 512;
    int k0 = 0, k1 = 4096;
    if (MIX == 0) { k0 = (qb > 0 ? qb - 1 : 0) * 128; k1 = (qb + 2 < 32 ? qb + 2 : 32) * 128; }
    const int r0 = MCTX + b * 4096 + k0;
    if (MIX == 0) {
      K0 = (const u16*)(ws + W_KCA) + (size_t)c0 * 128 + g * 64; V0 = (const u16*)(ws + W_VCAT) + ((size_t)(b * 2 + g) * 64) * 512;
      K1 = (const u16*)(ws + W_KA) + (size_t)r0 * 128 + g * 64;
      V1 = (const u16*)(ws + W_VAT) + (size_t)MCTX * 128 + ((size_t)(b * 2 + g) * 64) * 4096 + k0;
    } else if (MIX == 1) {
      K0 = (const u16*)(ws + W_KBNC) + (size_t)c0 * 512 + h * 64; R0 = (const u16*)(ws + W_KRC) + (size_t)c0 * 32; V0 = (const u16*)(ws + W_VBTC) + ((size_t)(b * 8 + h) * 64) * 512;
      K1 = (const u16*)(ws + W_KBN) + (size_t)r0 * 512 + h * 64; R1p = (const u16*)(ws + W_KR) + (size_t)r0 * 32;
      V1 = (const u16*)(ws + W_VBT) + (size_t)MCTX * 512 + ((size_t)(b * 8 + h) * 64) * 4096 + k0;
    } else {
      K0 = (const u16*)(ws + W_KCC) + (size_t)c0 * 128 + g * 64; V0 = (const u16*)(ws + W_VCCT) + ((size_t)(b * 2 + g) * 64) * 512;
      K1 = (const u16*)(ws + W_KC) + (size_t)r0 * 128 + g * 64;
      V1 = (const u16*)(ws + W_VCT) + (size_t)MCTX * 128 + ((size_t)(b * 2 + g) * 64) * 4096 + k0;
    }
    vs0 = 512; nt0 = 8; vs1 = 4096; nt1 = (k1 - k0) >> 6; pos1 = k0;
  }
  const int ntot = nt0 + nt1;

  float m_run = -1e30f, l_run = 0.f;
  if (MIX == 0) { m_run = P.in[I_SINK][l * 8 + h] * LOG2E; l_run = (hh == 0) ? 1.f : 0.f; }
  f32x16 o0, o1, mref;
#pragma unroll
  for (int i = 0; i < 16; ++i) { o0[i] = 0.f; o1[i] = 0.f; mref[i] = 0.f; }

  const int krow = wv * 8 + (lane >> 3);
  const int kch = (lane & 7) ^ (((lane >> 4) + 4 * (wv & 1)) & 7);
  const int rrow = wv * 16 + (lane >> 2), rch = (lane & 3) ^ ((lane >> 4) & 3);
  char* dl = smem + wv * 1024 + lane * 16;
  const u16* kq = K0 + (size_t)krow * KST + kch * 8;
  const u16* vq = V0 + (size_t)krow * vs0 + kch * 8;
  const u16* rq = (MIX == 1) ? R0 + (size_t)rrow * 32 + rch * 8 : nullptr;
  int vhi = 32 * vs0, nreq = 0, slot_off = 0;
  auto issue = [&](int) {
    char* d = dl + slot_off;
    __builtin_amdgcn_global_load_lds(kq, LDS_PTR(d), 16, 0, 0);
    __builtin_amdgcn_global_load_lds(kq + 32 * KST, LDS_PTR(d + 4096), 16, 0, 0);
    __builtin_amdgcn_global_load_lds(vq, LDS_PTR(d + 12288), 16, 0, 0);
    __builtin_amdgcn_global_load_lds(vq + vhi, LDS_PTR(d + 12288 + 4096), 16, 0, 0);
    if (MIX == 1) __builtin_amdgcn_global_load_lds(rq, LDS_PTR(d + 8192), 16, 0, 0);
    kq += 64 * KST; vq += 64; if (MIX == 1) rq += 64 * 32;
    slot_off = (slot_off == 40960) ? 0 : slot_off + 20480;
    if (++nreq == nt0) {
      kq = K1 + (size_t)krow * KST + kch * 8;
      vq = V1 + (size_t)krow * vs1 + kch * 8;
      if (MIX == 1) rq = R1p + (size_t)rrow * 32 + rch * 8;
      vhi = 32 * vs1;
    }
  };
  const int keyr = (r & 0x13) | ((r & 4) << 1) | ((r & 8) >> 1);
  const int qpos = qb * 128 + wv * 32 + r;

#pragma unroll
  for (int s = 0; s < NS; ++s) asm volatile("" :: "v"(qf[s]));
  asm volatile("s_waitcnt vmcnt(0)" ::: "memory");
  __builtin_amdgcn_s_barrier();
  issue(0);
  issue(1);
  int rcur = 0;
  for (int ti = 0; ti < ntot; ++ti) {
    if (ti + 1 < ntot) { if (MIX == 1) asm volatile("s_waitcnt vmcnt(5)" ::: "memory"); else asm volatile("s_waitcnt vmcnt(4)" ::: "memory"); }
    else asm volatile("s_waitcnt vmcnt(0)" ::: "memory");
    __builtin_amdgcn_s_barrier();
    asm volatile("" ::: "memory");
    if (ti + 2 < ntot && !(PROBE_VAR == 2 && dummy)) issue(ti + 2);
    const int cur = rcur;
    rcur = (rcur == 40960) ? 0 : rcur + 20480;
    bf16x8 kf[2 * NS], vf[8];
#pragma unroll
    for (int s = 0; s < NS; ++s) {
#pragma unroll
      for (int kt2 = 0; kt2 < 2; ++kt2) {
        const int key = kt2 * 32 + keyr;
        int addr;
        if (s < 4) addr = cur + key * 128 + (((s * 2 + hh) ^ ((key >> 1) & 7)) << 4);
        else addr = cur + 8192 + key * 64 + ((((s - 4) * 2 + hh) ^ ((key >> 2) & 3)) << 4);
        kf[2 * s + kt2] = *(const bf16x8*)(smem + addr);
      }
    }
#pragma unroll
    for (int ks = 0; ks < 4; ++ks) {
#pragma unroll
      for (int dt = 0; dt < 2; ++dt) {
        const int d = dt * 32 + r;
        vf[2 * ks + dt] = *(const bf16x8*)(smem + cur + 12288 + d * 128 + (((ks * 2 + hh) ^ ((d >> 1) & 7)) << 4));
      }
    }
    f32x16 s0, s1;
    s0 = __builtin_amdgcn_mfma_f32_32x32x16_bf16(kf[0], qf[0], mref, 0, 0, 0);
    s1 = __builtin_amdgcn_mfma_f32_32x32x16_bf16(kf[1], qf[0], mref, 0, 0, 0);
#pragma unroll
    for (int s = 1; s < NS; ++s) {
      s0 = __builtin_amdgcn_mfma_f32_32x32x16_bf16(kf[2 * s], qf[s], s0, 0, 0, 0);
      s1 = __builtin_amdgcn_mfma_f32_32x32x16_bf16(kf[2 * s + 1], qf[s], s1, 0, 0, 0);
    }
    if (MIX == 0 && ti >= nt0) {
      const int kb = pos1 + (ti - nt0) * 64;
      const int qw = qb * 128 + __builtin_amdgcn_readfirstlane(wv) * 32;
      const bool inside = (kb + 63 - qw <= 128) && (qw + 31 - kb <= 128);
      const int kp0 = kb + 8 * hh;
      if (!inside) {
#pragma unroll
      for (int i = 0; i < 16; ++i) {
        const int ko = 16 * (i >> 3) + (i & 7);
        int d0 = qpos - (kp0 + ko); d0 = d0 < 0 ? -d0 : d0;
        int d1 = qpos - (kp0 + 32 + ko); d1 = d1 < 0 ? -d1 : d1;
        if (d0 > 128) s0[i] = -1e30f;
        if (d1 > 128) s1[i] = -1e30f;
      }
      }
    }
    if (ti == 0) {
      float mx = s0[0];
#pragma unroll
      for (int i = 1; i < 16; ++i) mx = fmaxf(mx, s0[i]);
#pragma unroll
      for (int i = 0; i < 16; ++i) mx = fmaxf(mx, s1[i]);
      mx = fmaxf(mx, __shfl_xor(mx, 32));
      const float m_new = fmaxf(m_run, mx);
      l_run *= __builtin_amdgcn_exp2f(m_run - m_new);
      m_run = m_new;
#pragma unroll
      for (int i = 0; i < 16; ++i) { s0[i] -= m_new; s1[i] -= m_new; mref[i] = -m_new; }
    }
    f32x2_t ps2 = {0.f, 0.f};
#pragma unroll
    for (int i = 0; i < 16; i += 2) {
      f32x2_t v = {__builtin_amdgcn_exp2f(s0[i]), __builtin_amdgcn_exp2f(s0[i + 1])};
      ps2 += v; s0[i] = v[0]; s0[i + 1] = v[1];
    }
#pragma unroll
    for (int i = 0; i < 16; i += 2) {
      f32x2_t v = {__builtin_amdgcn_exp2f(s1[i]), __builtin_amdgcn_exp2f(s1[i + 1])};
      ps2 += v; s1[i] = v[0]; s1[i + 1] = v[1];
    }
    float psum = ps2[0] + ps2[1];
    if (__builtin_amdgcn_ballot_w64(psum > 4096.f) != 0ull) {
      float pm = s0[0];
#pragma unroll
      for (int i = 1; i < 16; ++i) pm = fmaxf(pm, s0[i]);
#pragma unroll
      for (int i = 0; i < 16; ++i) pm = fmaxf(pm, s1[i]);
      pm = fmaxf(fmaxf(pm, __shfl_xor(pm, 32)), 1.f);
      const float f = 1.f / pm;
      m_run += __builtin_amdgcn_logf(pm);
#pragma unroll
      for (int i = 0; i < 16; ++i) mref[i] = -m_run;
      psum *= f; l_run *= f;
#pragma unroll
      for (int i = 0; i < 16; ++i) { s0[i] *= f; s1[i] *= f; o0[i] *= f; o1[i] *= f; }
    }
    l_run += psum;
    bf16x8 pb[4];
#pragma unroll
    for (int u = 0; u < 2; ++u) {
      union { bf16x8 v; unsigned w[4]; } t0, t1;
#pragma unroll
      for (int j = 0; j < 4; ++j) { t0.w[j] = pk2(s0[8 * u + 2 * j], s0[8 * u + 2 * j + 1]); t1.w[j] = pk2(s1[8 * u + 2 * j], s1[8 * u + 2 * j + 1]); }
      pb[u] = t0.v; pb[2 + u] = t1.v;
    }
#pragma unroll
    for (int ks = 0; ks < 4; ++ks) {
#pragma unroll
      for (int dt = 0; dt < 2; ++dt) {
        if (dt == 0) o0 = __builtin_amdgcn_mfma_f32_32x32x16_bf16(vf[2 * ks], pb[ks], o0, 0, 0, 0);
        else o1 = __builtin_amdgcn_mfma_f32_32x32x16_bf16(vf[2 * ks + 1], pb[ks], o1, 0, 0, 0);
      }
    }
  }
  const float lt = l_run + __shfl_xor(l_run, 32);
  const float inv = 1.f / lt;
  u16* ob = dummy ? (u16*)(ws + W_H) : qbase;
#pragma unroll
  for (int i4 = 0; i4 < 4; ++i4) {
    f32x4 a = {o0[4 * i4] * inv, o0[4 * i4 + 1] * inv, o0[4 * i4 + 2] * inv, o0[4 * i4 + 3] * inv};
    f32x4 c = {o1[4 * i4] * inv, o1[4 * i4 + 1] * inv, o1[4 * i4 + 2] * inv, o1[4 * i4 + 3] * inv};
    st4bf(ob + tiled_off(qrow, h * 64 + 4 * hh + 8 * i4, qld), a);
    st4bf(ob + tiled_off(qrow, h * 64 + 32 + 4 * hh + 8 * i4, qld), c);
  }
}

__device__ __forceinline__ void attn_phase(const Params& P, int l, char* smem, bool dummy) {
  for (int i = blockIdx.x; i < 4608; i += gridDim.x) {
    int grp, b, h, qb; bool lat;
    if (i < 3072) {
      const int j = i & 1023, jp = (j & 7) * 128 + (j >> 3);
      grp = i >> 10; lat = true; b = jp >> 8; h = (jp >> 5) & 7; qb = jp & 31;
    } else {
      const int k = i - 3072, j = k & 511, jp = (j & 7) * 64 + (j >> 3);
      grp = k >> 9; lat = false; b = jp >> 4; h = (jp >> 1) & 7; qb = jp & 1;
    }
    if (grp == 0) attn_unit<1>(P, l, lat, b, h, qb, smem, dummy);
    else if (grp == 1) attn_unit<2>(P, l, lat, b, h, qb, smem, dummy);
    else attn_unit<0>(P, l, lat, b, h, qb, smem, dummy);
  }
}


#define XB_TMO      128
#define XB_XCNT(j)  (256  + 64 * (j))
#define XB_XSUB(j)  (1280 + 64 * (j))
#define XB_XGEN(j)  (2304 + 64 * (j))
#define XB_TOP      3328
#define XB_TOPGEN   3392
#define XCD_BAR_WORDS 3456
#define XB_SPIN_CAP (1u << 20)
__device__ __forceinline__ unsigned xb_ld(unsigned* p) { return __hip_atomic_load(p, __ATOMIC_RELAXED, __HIP_MEMORY_SCOPE_AGENT); }
__device__ __forceinline__ unsigned xb_add(unsigned* p, unsigned v) { return __hip_atomic_fetch_add(p, v, __ATOMIC_RELAXED, __HIP_MEMORY_SCOPE_AGENT); }
__device__ __forceinline__ unsigned xb_xcc_id() { return (unsigned)__builtin_amdgcn_s_getreg((3 << 11) | 20) & 0xFu; }
#define XB_SPIN(cond, bar) do { unsigned _sp = 0; while (cond) { __builtin_amdgcn_s_sleep(1); \
    if ((++_sp & 255u) == 0u) { if (xb_ld(&(bar)[XB_TMO])) break; if (_sp > XB_SPIN_CAP) { atomicAdd(&(bar)[XB_TMO], 1u); break; } } } } while (0)
__device__ __forceinline__ void xcd_barrier_complete(unsigned* bar, unsigned x, unsigned& nloc, unsigned& nx) {
  const unsigned G = gridDim.x;
  unsigned sum, cnt, mine, sp = 0u;
  for (;;) {
    sum = 0u; cnt = 0u; mine = 0u;
#pragma unroll
    for (unsigned j = 0; j < 16; ++j) { const unsigned c = xb_ld(&bar[XB_XCNT(j)]); sum += c; cnt += (c > 0u) ? 1u : 0u; mine = (j == x) ? c : mine; }
    if (sum == G) break;
    __builtin_amdgcn_s_sleep(1);
    if ((++sp & 255u) == 0u) { if (xb_ld(&bar[XB_TMO])) break; if (sp > XB_SPIN_CAP) { atomicAdd(&bar[XB_TMO], 1u); break; } }
  }
  nloc = mine > 0u ? mine : 1u; nx = cnt > 0u ? cnt : 1u;
}
__device__ __forceinline__ void xcd_barrier(unsigned* bar, unsigned x, unsigned& nloc, unsigned& nx) {
  asm volatile("s_waitcnt vmcnt(0)" ::: "memory");
  __syncthreads();
  if (threadIdx.x == 0) {
    __builtin_amdgcn_s_waitcnt(0);
    if (nloc == 0u) xcd_barrier_complete(bar, x, nloc, nx);
    const unsigned old = xb_add(&bar[XB_XSUB(x)], 1u);
    const unsigned gen = old / nloc;
    if (old + 1u == (gen + 1u) * nloc) {
      __builtin_amdgcn_fence(__ATOMIC_RELEASE, "agent");
      asm volatile("s_waitcnt vmcnt(0)" ::: "memory");
      const unsigned og = xb_add(&bar[XB_TOP], 1u);
      const unsigned tg = og / nx;
      if (og + 1u == (tg + 1u) * nx) xb_add(&bar[XB_TOPGEN], 1u);
      else XB_SPIN(xb_ld(&bar[XB_TOPGEN]) == tg, bar);
      __builtin_amdgcn_fence(__ATOMIC_ACQUIRE, "agent");
      xb_add(&bar[XB_XGEN(x)], 1u);
      asm volatile("s_waitcnt vmcnt(0)" ::: "memory");
    } else {
      XB_SPIN(xb_ld(&bar[XB_XGEN(x)]) == gen, bar);
      __builtin_amdgcn_fence(__ATOMIC_ACQUIRE, "agent");
      asm volatile("s_waitcnt vmcnt(0)" ::: "memory");
    }
  }
  __syncthreads();
}

constexpr int NPHASE = 2 + 9 * DEPTH;
constexpr int LDS_BYTES = 73728;

__global__ void __launch_bounds__(256, 2) fwd_kernel(Params PA, int ph_lo, int ph_hi) {
  extern __shared__ __attribute__((aligned(16))) char smem[];
  const Params& P = PA;
  unsigned char* ws = P.ws;
#if MK_COOP
  unsigned* bar = (unsigned*)(ws + W_BAR);
  const unsigned xb_x = xb_xcc_id();
  unsigned xb_nloc = 0u, xb_nx = 0u;
  if (threadIdx.x == 0) (void)xb_add(&bar[XB_XCNT(xb_x)], 1u);
#endif
  for (int ph = ph_lo; ph < ph_hi; ++ph) {
    if (ph == 0) {
      const int nitems = 384 + 192 + CONV_ITEMS;
      for (int it = blockIdx.x; it < nitems; it += gridDim.x) {
        if (it < 384) mod_item(P, it, smem);
        else if (it < 576) { float4* z = (float4*)(ws + W_SSQ) + (size_t)(it - 384) * 256 + tidx(); *z = make_float4(0.f, 0.f, 0.f, 0.f); }
        else convert_item(P, 0, it - 576, smem);
      }
    } else if (ph == 1) {
#if PROBE_DUP == 1
      rows_phase(P, 0, 0);
      xcd_barrier(bar, xb_x, xb_nloc, xb_nx);
      for (int it = blockIdx.x; it < CONV_ITEMS; it += gridDim.x) convert_item(P, 0, it, smem);
      xcd_barrier(bar, xb_x, xb_nloc, xb_nx);
#endif
      rows_phase(P, 0, 0);
    } else {
      const int l = (ph - 2) / 9, sub = (ph - 2) % 9;
#if PROBE_SUB >= 0
      for (int prep = 0; prep < ((sub == PROBE_SUB) ? 2 : 1); ++prep) {
      if (prep) xcd_barrier(bar, xb_x, xb_nloc, xb_nx);
#endif
      if (sub == 0) {
        constexpr int NTN = NINP / 128, T = (MT / 256) * NTN;
        gemm_phase_big<true, true>((const u16*)(ws + W_H), 1024, (const u16*)(ws + W_WIN), 1024, T, NTN, smem,
          [&](int m0, int n0, f32x4 (&acc)[2][4][4]) {
#pragma unroll
            for (int mh = 0; mh < 2; ++mh) { const WavePos w = wave_pos_big(m0, n0, mh); epi_win(P, l, w, acc[mh], PROBE_FIRST); }
          });
      } else if (sub == 1) {
        constexpr int T0 = 192 * 6, T1 = 192 * 8, T2 = 16 * 8;
        const float* ssq = (const float*)(ws + W_SSQ) + (size_t)l * 2 * MT;
        for (int t = blockIdx.x; t < T0 + T1 + T2; t += gridDim.x) {
          f32x4 acc[4][4]; zero_acc(acc);
          int kind, mt, nt, K; const u16 *X, *W;
          if (t < T0) { kind = 0; tile_map(t, T0, 6, mt, nt); X = (const u16*)(ws + W_QBD); W = (const u16*)(ws + W_WQ); K = 384; }
          else if (t < T0 + T1) { kind = 1; tile_map(t - T0, T1, 8, mt, nt); X = (const u16*)(ws + W_KVBD); W = (const u16*)(ws + W_WKV); K = 256; }
          else { kind = 2; const int tt = t - T0 - T1; mt = tt >> 3; nt = tt & 7; X = (const u16*)(ws + W_CKVC); W = (const u16*)(ws + W_WKVC); K = 256; }
          gemm_core<false, false>(X, K, W, K, mt * 128, nt * 128, smem, acc);
          const WavePos w = wave_pos(mt * 128, nt * 128);
          if (kind < 2) {
            const float* sq = ssq + (kind ? MT : 0);
            const float rk = kind ? (1.f / 256.f) : (1.f / 384.f);
            const float qs = kind ? 1.f : QSC_B;
#pragma unroll
            for (int mi = 0; mi < 4; ++mi) {
              const float rs = rsqrtf(sq[w.mb + mi * 16 + w.fr] * rk + EPS) * qs;
#pragma unroll
              for (int ni = 0; ni < 4; ++ni) acc[ni][mi] *= rs;
            }
          }
          if (kind == 0) {
            if (w.mb >= MCTX && w.nb >= 512) rope32(w, acc, 4);
            store_all_tiled((u16*)(ws + W_QB), 768, w.nb, w, acc);
          } else if (w.nb < 512) {
            store_all((u16*)(ws + (kind == 1 ? W_KBN : W_KBNC)), 512, w.nb, w, acc);
          } else if (kind == 1) {
            store_vt((u16*)(ws + W_VBT), 8, (w.nb - 512) >> 6, w, acc);
          } else {
            u16* VT = (u16*)(ws + W_VBTC);
            const int head = (w.nb - 512) >> 6;
#pragma unroll
            for (int mi = 0; mi < 4; ++mi) {
              const int m = w.mb + mi * 16 + w.fr, b = m >> 9, s = m & 511;
              u16* bp = VT + ((size_t)(b * 8 + head) * 64) * 512 + s;
#pragma unroll
              for (int ni = 0; ni < 4; ++ni)
#pragma unroll
                for (int j = 0; j < 4; ++j) bp[(size_t)(ni * 16 + w.fq * 4 + j) * 512] = (u16)(pk2(acc[ni][mi][j], 0.f) & 0xffffu);
            }
          }
        }
        {
          const int lane = tidx() & 63, gw = blockIdx.x * 4 + (tidx() >> 6), nw = gridDim.x * 4;
          const float4 g = *(const float4*)(P.in[I_GKVA] + l * 256 + lane * 4);
          for (int m = gw; m < MCTX; m += nw) {
            const float rs = rsqrtf(ssq[MT + m] * (1.f / 256.f) + EPS);
            float4* p = (float4*)(P.out + O_NCKV + ((size_t)(((m >> 8) * 4 + l) * 256 + (m & 255))) * 256 + lane * 4);
            float4 v = *p;
            v.x *= rs * g.x; v.y *= rs * g.y; v.z *= rs * g.z; v.w *= rs * g.w;
            *p = v;
          }
        }
      } else if (sub == 2) {
#if PROBE_DUP == 2
        attn_phase(P, l, smem, true);
        xcd_barrier(bar, xb_x, xb_nloc, xb_nx);
#endif
        attn_phase(P, l, smem, false);
      } else if (sub == 3) {
        constexpr int T = 192 * 8;
        const u16* G = (const u16*)(ws + W_GATES);
        for (int t = blockIdx.x; t < T; t += gridDim.x) {
          int mt, nt; tile_map(t, T, 8, mt, nt);
          const WavePos w = wave_pos(mt * 128, nt * 128);
          f32x4 tot[4][4]; zero_acc(tot);
#pragma unroll 1
          for (int br = 0; br < 3; ++br) {
            f32x4 acc[4][4]; zero_acc(acc);
            const u16* A = br == 0 ? (const u16*)(ws + W_QA) : (br == 1 ? (const u16*)(ws + W_QB) : (const u16*)(ws + W_QC));
            gemm_core<true, true>(A, br == 1 ? 768 : 512, (const u16*)(ws + W_WO3) + (size_t)br * 1024 * 512, 512, mt * 128, nt * 128, smem, acc);
#pragma unroll
            for (int mi = 0; mi < 4; ++mi) {
              const u16* gp = G + (size_t)(w.mb + mi * 16 + w.fr) * 3072 + br * 1024 + w.nb + w.fq * 4;
#pragma unroll
              for (int ni = 0; ni < 4; ++ni) {
                const uint2 gb = *(const uint2*)(gp + ni * 16);
                tot[ni][mi][0] += bflo(gb.x) * acc[ni][mi][0]; tot[ni][mi][1] += bfhi(gb.x) * acc[ni][mi][1];
                tot[ni][mi][2] += bflo(gb.y) * acc[ni][mi][2]; tot[ni][mi][3] += bfhi(gb.y) * acc[ni][mi][3];
              }
            }
          }
          store_all_tiled((u16*)(ws + W_MBUF), 1024, w.nb, w, tot);
        }
      } else if (sub == 4) {
        constexpr int T = 192 * 8;
        for (int t = blockIdx.x; t < T; t += gridDim.x) {
          int mt, nt; tile_map(t, T, 8, mt, nt);
          f32x4 acc[4][4]; zero_acc(acc);
          gemm_core<true, true>((const u16*)(ws + W_MBUF), 1024, (const u16*)(ws + W_WOUT), 1024, mt * 128, nt * 128, smem, acc);
          const WavePos w = wave_pos(mt * 128, nt * 128);
          store_all((u16*)(ws + W_T), 1024, w.nb, w, acc);
        }
      } else if (sub == 5) {
        rows_phase(P, 1, l);
      } else if (sub == 6) {
        constexpr int T = 96 * 32;
#if PROBE_DUP == 6
        for (int rep = 0; rep < 2; ++rep) {
        if (rep) xcd_barrier(bar, xb_x, xb_nloc, xb_nx);
#endif
        gemm_phase_big<true, true>((const u16*)(ws + W_H), 1024, (const u16*)(ws + W_W1), 1024, T, 32, smem,
          [&](int m0, int n0, f32x4 (&acc)[2][4][4]) {
#pragma unroll
            for (int mh = 0; mh < 2; ++mh) {
              const WavePos w = wave_pos_big(m0, n0, mh);
#pragma unroll
              for (int ni = 0; ni < 4; ++ni)
#pragma unroll
                for (int mi = 0; mi < 4; ++mi)
#pragma unroll
                  for (int j = 0; j < 4; ++j) { const float v = fmaxf(acc[mh][ni][mi][j], 0.f); acc[mh][ni][mi][j] = v * v; }
              store_all_tiled((u16*)(ws + W_U), 4096, w.nb, w, acc[mh]);
            }
          });
#if PROBE_DUP == 6
        }
#endif
      } else if (sub == 7) {
        constexpr int T = 192 * 8;
        for (int t = blockIdx.x; t < T; t += gridDim.x) {
          int mt, nt; tile_map(t, T, 8, mt, nt);
          f32x4 acc[4][4]; zero_acc(acc);
          gemm_core<true, true>((const u16*)(ws + W_U), 4096, (const u16*)(ws + W_W2), 4096, mt * 128, nt * 128, smem, acc);
          const WavePos w = wave_pos(mt * 128, nt * 128);
          store_all((u16*)(ws + W_T), 1024, w.nb, w, acc);
        }
      } else {
        if (l + 1 < DEPTH)
          for (int it = blockIdx.x; it < CONV_ITEMS; it += gridDim.x) convert_item(P, l + 1, it, smem);
        rows_phase(P, 2, l);
      }
#if PROBE_SUB >= 0
      }
#endif
    }
#if MK_COOP
    if (ph + 1 < ph_hi) {
      if (ph_hi < 0) cg::this_grid().sync();
      xcd_barrier(bar, xb_x, xb_nloc, xb_nx);
    }
#endif
  }
}

extern "C" void kernel_launch(void* const* d_in, const int* in_sizes, int n_in, void* d_out, int out_size, void* d_ws, size_t ws_size,
                              hipStream_t stream) {
  static int grid = 0;
  if (grid == 0) {
    int dev = 0, cus = 0, per_cu = 0;
    hipGetDevice(&dev);
    hipDeviceGetAttribute(&cus, hipDeviceAttributeMultiprocessorCount, dev);
    hipFuncSetAttribute((const void*)fwd_kernel, hipFuncAttributeMaxDynamicSharedMemorySize, LDS_BYTES);
    hipOccupancyMaxActiveBlocksPerMultiprocessor(&per_cu, (const void*)fwd_kernel, 256, LDS_BYTES);
    if (per_cu < 1) per_cu = 1;
    if (per_cu > 2) per_cu = 2;
    grid = cus * per_cu;
    if (n_in != 30 || ws_size < W_END) { fprintf(stderr, "kernel_launch: unexpected n_in %d / ws_size %zu (need %zu)\n", n_in, ws_size, (size_t)W_END); }
  }
  Params p{};
  for (int i = 0; i < 30; ++i) p.in[i] = (const float*)d_in[i];
  p.out = (float*)d_out;
  p.ws = (unsigned char*)d_ws;
#if MK_COOP
  hipMemsetAsync((unsigned char*)d_ws + W_BAR, 0, XCD_BAR_WORDS * 4, stream);
  int lo = 0, hi = NPHASE;
  void* args[] = {&p, &lo, &hi};
  hipError_t e = hipLaunchCooperativeKernel((const void*)fwd_kernel, dim3(grid), dim3(256), args, LDS_BYTES, stream);
  if (e != hipSuccess) fprintf(stderr, "cooperative launch failed: %s (grid %d)\n", hipGetErrorString(e), grid);
#else
  for (int ph = 0; ph < NPHASE; ++ph) hipLaunchKernelGGL(fwd_kernel, dim3(grid), dim3(256), LDS_BYTES, stream, p, ph, ph + 1);
#endif
}
```

```cpp
#include <hip/hip_runtime.h>
#include <hip/hip_cooperative_groups.h>
#include <stdint.h>
#include <stdio.h>
namespace cg = cooperative_groups;

#ifndef PROBE_VAR
#define PROBE_VAR 0
#endif
#ifndef PROBE_SUB
#define PROBE_SUB -1
#endif
#if PROBE_SUB >= 0
#define PROBE_FIRST (prep == 0)
#else
#define PROBE_FIRST true
#endif
#ifndef PROBE_DUP
#define PROBE_DUP 0
#endif
#ifndef MK_COOP
#define MK_COOP 1
#endif

typedef unsigned short u16;
typedef __attribute__((ext_vector_type(8))) short bf16x8;
typedef __attribute__((ext_vector_type(4))) float f32x4;
typedef __attribute__((ext_vector_type(16))) float f32x16;
typedef __attribute__((ext_vector_type(2))) float f32x2_t;
typedef __attribute__((ext_vector_type(2))) __bf16 bf16x2_t;

constexpr int DM = 1024, MCTX = 8192, MLAT = 16384, MT = 24576, DEPTH = 4;
constexpr int NIN = 5280, NINP = 5376;
constexpr float EPS = 1e-6f;
constexpr float LOG2E = 1.4426950408889634f;
constexpr float L2THETA = 13.287712379549449f;
constexpr float QSC_AC = 0.125f * 1.4426950408889634f, QSC_B = 0.10206207261596575f * 1.4426950408889634f;

constexpr size_t O_NAK = 25165824, O_NAV = 29360128, O_NCKV = 33554432, O_NKR = 41943040, O_NCK = 42991616, O_NCV = 47185920;

constexpr size_t MiB = 1u << 20;
constexpr size_t W_WIN = 0, W_WQ = 11 * MiB, W_WKV = 12 * MiB, W_WKVC = 12 * MiB + 512 * 1024, W_WO3 = 13 * MiB, W_WOUT = 16 * MiB,
                 W_W1 = 18 * MiB, W_W2 = 26 * MiB;
constexpr size_t W_KCA = 34 * MiB, W_VCAT = 34 * MiB + 512 * 1024, W_KCC = 35 * MiB, W_VCCT = 35 * MiB + 512 * 1024, W_CKVC = 36 * MiB,
                 W_KRC = 37 * MiB, W_KBNC = 38 * MiB, W_VBTC = 40 * MiB;
constexpr size_t W_MOD = 42 * MiB, W_SSQ = 43 * MiB, W_BAR = 43 * MiB + 900 * 1024, W_H = 44 * MiB;
constexpr size_t R1 = 92 * MiB;
constexpr size_t W_QA = R1, W_KA = R1 + 24 * MiB, W_VAT = R1 + 30 * MiB, W_QBD = R1 + 36 * MiB, W_KVBD = R1 + 54 * MiB, W_QB = R1 + 66 * MiB,
                 W_KBN = R1 + 102 * MiB, W_VBT = R1 + 126 * MiB, W_KR = R1 + 150 * MiB, W_QC = R1 + 152 * MiB, W_KC = R1 + 176 * MiB,
                 W_VCT = R1 + 182 * MiB, W_GATES = R1 + 188 * MiB, W_END = R1 + 332 * MiB;
constexpr size_t W_T = R1 + 200 * MiB;
constexpr size_t W_U = R1;
constexpr size_t W_MBUF = W_KBN;

struct Params { const float* in[30]; float* out; unsigned char* ws; };
enum { I_XP = 0, I_XS, I_CAK, I_CAV, I_CCKV, I_CKR, I_CCK, I_CCV, I_C, I_CCTX, I_WMOD, I_BMOD, I_GPREMIX, I_GPOSTMIX, I_GPREMLP, I_GPOSTMLP,
       I_WIN, I_SINK, I_GQA, I_WQUP, I_GKVA, I_WKVUP, I_GQC, I_GKC, I_WOA, I_WOB, I_WOC, I_WOUT, I_W1, I_W2 };

__device__ __forceinline__ unsigned pk2(float lo, float hi) { f32x2_t v = {lo, hi}; bf16x2_t b = __builtin_convertvector(v, bf16x2_t); return __builtin_bit_cast(unsigned, b); }
__device__ __forceinline__ float bflo(unsigned u) { return __uint_as_float(u << 16); }
__device__ __forceinline__ float bfhi(unsigned u) { return __uint_as_float(u & 0xffff0000u); }
__device__ __forceinline__ float wave_sum(float v) {
#pragma unroll
  for (int o = 32; o >= 1; o >>= 1) v += __shfl_xor(v, o);
  return v;
}
__device__ __forceinline__ int tidx() { int t = threadIdx.x; asm volatile("" : "+v"(t)); return t; }
__device__ __forceinline__ uint4 ld16(const void* p) { return *(const uint4*)p; }
__device__ __forceinline__ void st4bf(u16* p, f32x4 v) { uint2 w; w.x = pk2(v[0], v[1]); w.y = pk2(v[2], v[3]); *(uint2*)p = w; }

__device__ __forceinline__ size_t tiled_off(int r, int k, int K) { return (size_t)(r & ~15) * K + (size_t)(k >> 5) * 512 + (r & 15) * 32 + (k & 31); }
__device__ __forceinline__ int perm_col(int type, int n) {
  if (type == 1) { if (n < 1408) return n; if (n < 1440) return 5248 + (n - 1408); return n - 32; }
  if (type == 2) { int h = n / 96, d = n - h * 96; return d < 64 ? h * 64 + d : 512 + h * 32 + (d - 64); }
  if (type == 3) { int h = n >> 7, d = n & 127; return d < 64 ? h * 64 + d : 512 + h * 64 + (d - 64); }
  return n;
}
__device__ __forceinline__ void conv_tile(const float* __restrict__ src, int K, int N, u16* __restrict__ dst, int k0, int n0, int type,
                                          const float* __restrict__ scale, char* smem, bool tiled = true) {
  float* T = (float*)smem;
  const int tid = tidx();
  {
    const int n = tid & 63, kr = tid >> 6;
#pragma unroll 4
    for (int i = 0; i < 16; ++i) {
      const int k = kr + 4 * i;
      float v = (n0 + n < N) ? src[(size_t)(k0 + k) * N + n0 + n] : 0.f;
      if (scale) v *= scale[k0 + k];
      T[k * 65 + n] = v;
    }
  }
  __syncthreads();
  {
    const int nl = tid >> 2, kc = (tid & 3) * 16, n = n0 + nl;
    if (n < N) {
      unsigned w[8];
#pragma unroll
      for (int j = 0; j < 8; ++j) w[j] = pk2(T[(kc + 2 * j) * 65 + nl], T[(kc + 2 * j + 1) * 65 + nl]);
      const int np = perm_col(type, n);
      u16* d = dst + (tiled ? tiled_off(np, k0 + kc, K) : (size_t)np * K + k0 + kc);
      *(uint4*)d = make_uint4(w[0], w[1], w[2], w[3]);
      *(uint4*)(d + 8) = make_uint4(w[4], w[5], w[6], w[7]);
    }
  }
  __syncthreads();
}

constexpr int CONV_ITEMS = 1328 + 72 + 64 + 64 + 384 + 256 + 1024 + 1024 + 800;

__device__ __forceinline__ void convert_item(const Params& P, int l, int it, char* smem) {
  unsigned char* ws = P.ws;
  const int tid = tidx();
  if (it < 1328) { conv_tile(P.in[I_WIN] + (size_t)l * 1024 * NIN, 1024, NIN, (u16*)(ws + W_WIN), (it & 15) * 64, (it >> 4) * 64, 1, nullptr, smem); return; }
  it -= 1328;
  if (it < 72) { conv_tile(P.in[I_WQUP] + (size_t)l * 384 * 768, 384, 768, (u16*)(ws + W_WQ), (it % 6) * 64, (it / 6) * 64, 2, P.in[I_GQA] + l * 384, smem, false); return; }
  it -= 72;
  if (it < 64) { conv_tile(P.in[I_WKVUP] + (size_t)l * 256 * 1024, 256, 1024, (u16*)(ws + W_WKV), (it & 3) * 64, (it >> 2) * 64, 3, P.in[I_GKVA] + l * 256, smem, false); return; }
  it -= 64;
  if (it < 64) { conv_tile(P.in[I_WKVUP] + (size_t)l * 256 * 1024, 256, 1024, (u16*)(ws + W_WKVC), (it & 3) * 64, (it >> 2) * 64, 3, nullptr, smem, false); return; }
  it -= 64;
  if (it < 384) {
    const int br = it >> 7, t = it & 127;
    const float *pa = P.in[I_WOA], *pb = P.in[I_WOB], *pc = P.in[I_WOC];
    asm volatile("" : "+s"(pa), "+s"(pb), "+s"(pc));
    conv_tile((br == 0 ? pa : (br == 1 ? pb : pc)) + (size_t)l * 512 * 1024, 512, 1024, (u16*)(ws + W_WO3) + (size_t)br * 1024 * 512, (t & 7) * 64, (t >> 3) * 64, 0, nullptr, smem);
    return;
  }
  it -= 384;
  if (it < 256) { conv_tile(P.in[I_WOUT] + (size_t)l * 1024 * 1024, 1024, 1024, (u16*)(ws + W_WOUT), (it & 15) * 64, (it >> 4) * 64, 0, nullptr, smem); return; }
  it -= 256;
  if (it < 1024) { conv_tile(P.in[I_W1] + (size_t)l * 1024 * 4096, 1024, 4096, (u16*)(ws + W_W1), (it & 15) * 64, (it >> 4) * 64, 0, nullptr, smem); return; }
  it -= 1024;
  if (it < 1024) { conv_tile(P.in[I_W2] + (size_t)l * 4096 * 1024, 4096, 1024, (u16*)(ws + W_W2), (it & 63) * 64, (it >> 6) * 64, 0, nullptr, smem); return; }
  it -= 1024;
  if (it < 512) {
    const float* src; u16* dst; int ncol, sh;
    const float *pa = P.in[I_CAK], *pb = P.in[I_CCK], *pc = P.in[I_CCKV];
    asm volatile("" : "+s"(pa), "+s"(pb), "+s"(pc));
    if (it < 128) { src = pa; dst = (u16*)(ws + W_KCA); ncol = 128; sh = 7; }
    else if (it < 256) { it -= 128; src = pb; dst = (u16*)(ws + W_KCC); ncol = 128; sh = 7; }
    else { it -= 256; src = pc; dst = (u16*)(ws + W_CKVC); ncol = 256; sh = 8; }
    const int e = (it * 256 + tid) * 8, row = e >> sh, c = e & (ncol - 1), b = row >> 9, s = row & 511;
    const float* sp = src + ((size_t)((b * 4 + l) * 512 + s)) * ncol + c;
    const float4 a = *(const float4*)sp, bb = *(const float4*)(sp + 4);
    *(uint4*)(dst + e) = make_uint4(pk2(a.x, a.y), pk2(a.z, a.w), pk2(bb.x, bb.y), pk2(bb.z, bb.w));
    return;
  }
  it -= 512;
  if (it < 32) {
    const int e = (it * 256 + tid) * 8, row = e >> 5, c = e & 31, b = row >> 9, s = row & 511;
    const float* sp = P.in[I_CKR] + ((size_t)((b * 4 + l) * 512 + s)) * 32 + c;
    const float4 a = *(const float4*)sp, bb = *(const float4*)(sp + 4);
    *(uint4*)((u16*)(ws + W_KRC) + e) = make_uint4(pk2(a.x, a.y), pk2(a.z, a.w), pk2(bb.x, bb.y), pk2(bb.z, bb.w));
    return;
  }
  it -= 32;
  {
    const float *pa = P.in[I_CAV], *pb = P.in[I_CCV];
    asm volatile("" : "+s"(pa), "+s"(pb));
    const float* src = pa; u16* dst = (u16*)(ws + W_VCAT);
    if (it >= 128) { it -= 128; src = pb; dst = (u16*)(ws + W_VCCT); }
    const int idx = it * 256 + tid, d = idx & 63, g = (idx >> 6) & 1, b = (idx >> 7) & 3, s8 = idx >> 9;
    const float* sp = src + ((size_t)((b * 4 + l) * 512 + s8 * 8)) * 128 + g * 64 + d;
    float v[8];
#pragma unroll
    for (int j = 0; j < 8; ++j) v[j] = sp[(size_t)j * 128];
    *(uint4*)(dst + ((size_t)((b * 2 + g) * 64 + d)) * 512 + s8 * 8) = make_uint4(pk2(v[0], v[1]), pk2(v[2], v[3]), pk2(v[4], v[5]), pk2(v[6], v[7]));
  }
}

__device__ __forceinline__ void mod_item(const Params& P, int it, char* smem) {
  float* sv = (float*)smem;
  float* red = (float*)(smem + 20480);
  const int tid = tidx(), l = it / 96, n0 = (it % 96) * 64;
  for (int e = tid; e < 5120; e += 256) {
    const int v = e >> 10, k = e & 1023;
    const float c = (v == 0) ? P.in[I_CCTX][k] : P.in[I_C][(v - 1) * 1024 + k];
    sv[e] = c / (1.f + __expf(-c));
  }
  __syncthreads();
  const int kq = tid >> 4, n4 = tid & 15;
  float acc[5][4];
#pragma unroll
  for (int v = 0; v < 5; ++v)
#pragma unroll
    for (int j = 0; j < 4; ++j) acc[v][j] = 0.f;
  const float* wp = P.in[I_WMOD] + ((size_t)l * 1024 + kq * 64) * 6144 + n0 + n4 * 4;
#pragma unroll 8
  for (int k = 0; k < 64; ++k) {
    const float4 w = *(const float4*)(wp + (size_t)k * 6144);
#pragma unroll
    for (int v = 0; v < 5; ++v) {
      const float s = sv[v * 1024 + kq * 64 + k];
      acc[v][0] += s * w.x; acc[v][1] += s * w.y; acc[v][2] += s * w.z; acc[v][3] += s * w.w;
    }
  }
#pragma unroll
  for (int v = 0; v < 5; ++v)
#pragma unroll
    for (int j = 0; j < 4; ++j) red[(kq * 5 + v) * 64 + n4 * 4 + j] = acc[v][j];
  __syncthreads();
  float* mod = (float*)(P.ws + W_MOD);
  for (int e = tid; e < 320; e += 256) {
    const int v = e >> 6, n = e & 63;
    float s = P.in[I_BMOD][l * 6144 + n0 + n];
#pragma unroll
    for (int q = 0; q < 16; ++q) s += red[(q * 5 + v) * 64 + n];
    mod[((size_t)l * 5 + v) * 6144 + n0 + n] = s;
  }
  __syncthreads();
}

__device__ __forceinline__ void rows_phase(const Params& P, int mode, int l) {
  const int lane = tidx() & 63, wid = tidx() >> 6;
  const int gw = blockIdx.x * 4 + wid, nw = gridDim.x * 4;
  const float* mod = (const float*)(P.ws + W_MOD);
  u16* H = (u16*)(P.ws + W_H);
  const u16* TB = (const u16*)(P.ws + W_T);
  const bool write_h = !(mode == 2 && l == DEPTH - 1);
  const int lh = (mode == 2) ? l + 1 : l;
  const float* gpost = (mode == 1) ? P.in[I_GPOSTMIX] + l * 1024 : P.in[I_GPOSTMLP] + l * 1024;
  const float* gpre = (mode == 1) ? P.in[I_GPREMLP] + l * 1024 : P.in[I_GPREMIX] + (write_h ? lh : 0) * 1024;
  for (int row = gw; row < MT; row += nw) {
    const int v = row < MCTX ? 0 : 1 + ((row - MCTX) >> 12);
    float* xp = P.out + (size_t)row * 1024;
    float x[16];
    if (mode == 0) {
      const float* src = row < MCTX ? P.in[I_XP] + (size_t)row * 1024 : P.in[I_XS] + (size_t)(row - MCTX) * 1024;
#pragma unroll
      for (int i = 0; i < 4; ++i) { const f32x4 av = __builtin_nontemporal_load((const f32x4*)(src + i * 256 + lane * 4)); const float4 a = make_float4(av[0], av[1], av[2], av[3]); x[4 * i] = a.x; x[4 * i + 1] = a.y; x[4 * i + 2] = a.z; x[4 * i + 3] = a.w; }
    } else {
      float t[16];
      float ss = 0.f;
#pragma unroll
      for (int i = 0; i < 4; ++i) {
        const f32x4 av = __builtin_nontemporal_load((const f32x4*)(xp + i * 256 + lane * 4));
        const float4 a = make_float4(av[0], av[1], av[2], av[3]);
        x[4 * i] = a.x; x[4 * i + 1] = a.y; x[4 * i + 2] = a.z; x[4 * i + 3] = a.w;
        typedef unsigned u32x2_t __attribute__((ext_vector_type(2)));
        const u32x2_t tv = __builtin_nontemporal_load((const u32x2_t*)(TB + (size_t)row * 1024 + i * 256 + lane * 4));
        uint2 tb; tb.x = tv[0]; tb.y = tv[1];
        t[4 * i] = bflo(tb.x); t[4 * i + 1] = bfhi(tb.x); t[4 * i + 2] = bflo(tb.y); t[4 * i + 3] = bfhi(tb.y);
      }
#pragma unroll
      for (int i = 0; i < 16; ++i) ss += t[i] * t[i];
      ss = wave_sum(ss);
      const float rstd = rsqrtf(ss * (1.f / 1024.f) + EPS);
      const float* gate = mod + ((size_t)l * 5 + v) * 6144 + (mode == 1 ? 2048 : 5120);
#pragma unroll
      for (int i = 0; i < 4; ++i) {
        const float4 gt = *(const float4*)(gate + i * 256 + lane * 4);
        const float4 gp = *(const float4*)(gpost + i * 256 + lane * 4);
        x[4 * i] += gt.x * (t[4 * i] * rstd * gp.x);
        x[4 * i + 1] += gt.y * (t[4 * i + 1] * rstd * gp.y);
        x[4 * i + 2] += gt.z * (t[4 * i + 2] * rstd * gp.z);
        x[4 * i + 3] += gt.w * (t[4 * i + 3] * rstd * gp.w);
      }
    }
#pragma unroll
    for (int i = 0; i < 4; ++i) __builtin_nontemporal_store((f32x4){x[4 * i], x[4 * i + 1], x[4 * i + 2], x[4 * i + 3]}, (f32x4*)(xp + i * 256 + lane * 4));
    if (write_h) {
      float ss = 0.f;
#pragma unroll
      for (int i = 0; i < 16; ++i) ss += x[i] * x[i];
      ss = wave_sum(ss);
      const float rstd = rsqrtf(ss * (1.f / 1024.f) + EPS);
      const float* mb = mod + ((size_t)lh * 5 + v) * 6144;
      const float* shp = mb + (mode == 1 ? 3072 : 0);
      const float* scp = mb + (mode == 1 ? 4096 : 1024);
#pragma unroll
      for (int i = 0; i < 4; ++i) {
        const float4 g = *(const float4*)(gpre + i * 256 + lane * 4);
        const float4 sc = *(const float4*)(scp + i * 256 + lane * 4);
        const float4 sh = *(const float4*)(shp + i * 256 + lane * 4);
        const float h0 = x[4 * i] * rstd * g.x * (1.f + sc.x) + sh.x;
        const float h1 = x[4 * i + 1] * rstd * g.y * (1.f + sc.y) + sh.y;
        const float h2 = x[4 * i + 2] * rstd * g.z * (1.f + sc.z) + sh.z;
        const float h3 = x[4 * i + 3] * rstd * g.w * (1.f + sc.w) + sh.w;
        uint2 w; w.x = pk2(h0, h1); w.y = pk2(h2, h3);
        *(uint2*)(H + tiled_off(row, i * 256 + lane * 4, 1024)) = w;
      }
    }
  }
}

#define LDS_PTR(p) ((__attribute__((address_space(3))) void*)(p))
__device__ __forceinline__ int swz4(int q) { return ((q & 1) << 1) | ((q >> 1) ^ (q & 1)); }
template <bool XT, bool WT>
__device__ __forceinline__ void gemm_core(const u16* __restrict__ X, int ldx, const u16* __restrict__ W, int K, int m0, int n0, char* smem,
                                          f32x4 (&acc)[4][4]) {
  const int tid = tidx(), lane = tid & 63, wid = tid >> 6;
  const int wn = wid >> 1, wm = wid & 1, fr = lane & 15, fq = lane >> 4;
  const int drow = wid * 16 + (lane >> 2);
  const int dch = (lane & 3) ^ swz4((lane >> 4) & 3);
  const u16* wg = W + (WT ? (size_t)(n0 + wid * 16) * K + (lane >> 2) * 32 : (size_t)(n0 + drow) * K) + dch * 8;
  const u16* xg = X + (XT ? (size_t)(m0 + wid * 16) * ldx + (lane >> 2) * 32 : (size_t)(m0 + drow) * ldx) + dch * 8;
  constexpr int KW = WT ? 512 : 32, KX = XT ? 512 : 32;
  const size_t wstep = (size_t)64 * K, xstep = (size_t)64 * ldx;
  char* dl = smem + wid * 1024 + lane * 16;
  auto issue = [&](int kt) {
    char* d = dl + (kt & 3) * 16384;
    const int kw = kt * KW, kx = kt * KX;
    __builtin_amdgcn_global_load_lds(wg + kw, LDS_PTR(d), 16, 0, 0);
    __builtin_amdgcn_global_load_lds(wg + wstep + kw, LDS_PTR(d + 4096), 16, 0, 0);
    __builtin_amdgcn_global_load_lds(xg + kx, LDS_PTR(d + 8192), 16, 0, 0);
    __builtin_amdgcn_global_load_lds(xg + xstep + kx, LDS_PTR(d + 8192 + 4096), 16, 0, 0);
  };
  const int nk = K >> 5;
  asm volatile("s_waitcnt vmcnt(0)" ::: "memory");
  __builtin_amdgcn_s_barrier();
  issue(0); issue(1); issue(2);
  const int co = (fq ^ swz4((fr >> 2) & 3)) << 4;
  const int aoff = (wn * 64 + fr) * 64 + co, boff = 8192 + (wm * 64 + fr) * 64 + co;
  bf16x8 a0[4], b0[4], a1[4], b1[4];
  asm volatile("s_waitcnt vmcnt(8)" ::: "memory");
  __builtin_amdgcn_s_barrier();
  asm volatile("" ::: "memory");
  issue(3);
#pragma unroll
  for (int i = 0; i < 4; ++i) { a0[i] = *(const bf16x8*)(smem + aoff + i * 1024); b0[i] = *(const bf16x8*)(smem + boff + i * 1024); }
#define GEMM_STEP(kt, AC, BC, AN, BN) do { \
    if ((kt) + 1 < nk) { \
      if ((kt) + 3 < nk) asm volatile("s_waitcnt vmcnt(8) lgkmcnt(0)" ::: "memory"); \
      else if ((kt) + 2 < nk) asm volatile("s_waitcnt vmcnt(4) lgkmcnt(0)" ::: "memory"); \
      else asm volatile("s_waitcnt vmcnt(0) lgkmcnt(0)" ::: "memory"); \
      __builtin_amdgcn_s_barrier(); \
      asm volatile("" ::: "memory"); \
      if ((kt) + 4 < nk) issue((kt) + 4); \
      const char* st_ = smem + (((kt) + 1) & 3) * 16384; \
      _Pragma("unroll") for (int i = 0; i < 4; ++i) { AN[i] = *(const bf16x8*)(st_ + aoff + i * 1024); BN[i] = *(const bf16x8*)(st_ + boff + i * 1024); } \
    } \
    _Pragma("unroll") for (int ni = 0; ni < 4; ++ni) \
      _Pragma("unroll") for (int mi = 0; mi < 4; ++mi) acc[ni][mi] = __builtin_amdgcn_mfma_f32_16x16x32_bf16(AC[ni], BC[mi], acc[ni][mi], 0, 0, 0); \
  } while (0)
  for (int kt = 0; kt < nk; kt += 2) {
    GEMM_STEP(kt, a0, b0, a1, b1);
    GEMM_STEP(kt + 1, a1, b1, a0, b0);
  }
#undef GEMM_STEP
}
__device__ __forceinline__ void tile_map_big(int t, int T, int ntn, int& mt, int& nt);
template <bool XT, bool WT, class Epi>
__device__ __forceinline__ void gemm_phase_big(const u16* __restrict__ X, int ldx, const u16* __restrict__ W, int K, int T, int ntn, char* smem, Epi epi) {
  int t = blockIdx.x;
  if (t >= T) return;
  const int tid = tidx(), lane = tid & 63, wid = tid >> 6;
  const int wn = wid >> 1, wm = wid & 1, fr = lane & 15, fq = lane >> 4;
  const int drow = wid * 16 + (lane >> 2);
  const int dch = (lane & 3) ^ swz4((lane >> 4) & 3);
  constexpr int KW = WT ? 512 : 32, KX = XT ? 512 : 32;
  const size_t woff = (WT ? (size_t)(wid * 16) * K + (lane >> 2) * 32 : (size_t)drow * K) + dch * 8;
  const size_t xoff = (XT ? (size_t)(wid * 16) * ldx + (lane >> 2) * 32 : (size_t)drow * ldx) + dch * 8;
  const size_t wstep = (size_t)64 * K, xstep = (size_t)64 * ldx;
  char* dl = smem + wid * 1024 + lane * 16;
  const u16 *wg, *xg;
  int rb = 0;
  auto issue = [&](int kt) {
    char* d = dl + ((rb + kt) % 3) * 24576;
    const int kw = kt * KW, kx = kt * KX;
    __builtin_amdgcn_global_load_lds(wg + kw, LDS_PTR(d), 16, 0, 0);
    __builtin_amdgcn_global_load_lds(wg + wstep + kw, LDS_PTR(d + 4096), 16, 0, 0);
    __builtin_amdgcn_global_load_lds(xg + kx, LDS_PTR(d + 8192), 16, 0, 0);
    __builtin_amdgcn_global_load_lds(xg + xstep + kx, LDS_PTR(d + 8192 + 4096), 16, 0, 0);
    __builtin_amdgcn_global_load_lds(xg + 2 * xstep + kx, LDS_PTR(d + 8192 + 8192), 16, 0, 0);
    __builtin_amdgcn_global_load_lds(xg + 3 * xstep + kx, LDS_PTR(d + 8192 + 12288), 16, 0, 0);
  };
  const int nk = K >> 5;
  const int co = (fq ^ swz4((fr >> 2) & 3)) << 4;
  const int aoff = (wn * 64 + fr) * 64 + co, boff = 8192 + (wm * 128 + fr) * 64 + co;
  int mt, nt;
  tile_map_big(t, T, ntn, mt, nt);
  wg = W + (size_t)(nt * 128) * K + woff;
  xg = X + (size_t)(mt * 256) * ldx + xoff;
  asm volatile("s_waitcnt vmcnt(0)" ::: "memory");
  __builtin_amdgcn_s_barrier();
  issue(0); issue(1);
  for (;;) {
    f32x4 acc[2][4][4];
#pragma unroll
    for (int mh = 0; mh < 2; ++mh)
#pragma unroll
      for (int i = 0; i < 4; ++i)
#pragma unroll
        for (int j = 0; j < 4; ++j) acc[mh][i][j] = (f32x4){0.f, 0.f, 0.f, 0.f};
    for (int kt = 0; kt < nk; ++kt) {
      if (kt + 1 < nk) asm volatile("s_waitcnt vmcnt(6)" ::: "memory");
      else asm volatile("s_waitcnt vmcnt(0)" ::: "memory");
      __builtin_amdgcn_s_barrier();
      asm volatile("" ::: "memory");
      if (kt + 2 < nk) issue(kt + 2);
      const char* st = smem + ((rb + kt) % 3) * 24576;
      bf16x8 a[4], b[8];
#pragma unroll
      for (int i = 0; i < 4; ++i) a[i] = *(const bf16x8*)(st + aoff + i * 1024);
#pragma unroll
      for (int i = 0; i < 8; ++i) b[i] = *(const bf16x8*)(st + boff + i * 1024);
#pragma unroll
      for (int mh = 0; mh < 2; ++mh)
#pragma unroll
        for (int ni = 0; ni < 4; ++ni)
#pragma unroll
          for (int mi = 0; mi < 4; ++mi) acc[mh][ni][mi] = __builtin_amdgcn_mfma_f32_16x16x32_bf16(a[ni], b[mh * 4 + mi], acc[mh][ni][mi], 0, 0, 0);
    }
    rb = (rb + nk) % 3;
    const int m0 = mt * 256, n0 = nt * 128;
    const int tn = t + gridDim.x;
    if (tn < T) {
      tile_map_big(tn, T, ntn, mt, nt);
      wg = W + (size_t)(nt * 128) * K + woff;
      xg = X + (size_t)(mt * 256) * ldx + xoff;
      issue(0); issue(1);
    }
    epi(m0, n0, acc);
    if (tn >= T) break;
    t = tn;
  }
}
__device__ __forceinline__ void tile_map_big(int t, int T, int ntn, int& mt, int& nt) {
  const int tp = (t & 7) * (T >> 3) + (t >> 3);
  const int g = 4 * ntn, ms = tp / g, rem = tp - ms * g;
  nt = rem >> 2; mt = ms * 4 + (rem & 3);
}
__device__ __forceinline__ void zero_acc(f32x4 (&acc)[4][4]) {
#pragma unroll
  for (int i = 0; i < 4; ++i)
#pragma unroll
    for (int j = 0; j < 4; ++j) acc[i][j] = (f32x4){0.f, 0.f, 0.f, 0.f};
}
__device__ __forceinline__ void tile_map(int t, int T, int ntn, int& mt, int& nt) {
  const int tp = (t & 7) * (T >> 3) + (t >> 3);
  const int g = 8 * ntn, ms = tp / g, rem = tp - ms * g;
  nt = rem >> 3; mt = ms * 8 + (rem & 7);
}

struct WavePos { int nb, mb, fr, fq; };
__device__ __forceinline__ WavePos wave_pos(int m0, int n0) {
  const int lane = tidx() & 63, wid = tidx() >> 6;
  WavePos w; w.nb = n0 + (wid >> 1) * 64; w.mb = m0 + (wid & 1) * 64; w.fr = lane & 15; w.fq = lane >> 4; return w;
}
__device__ __forceinline__ WavePos wave_pos_big(int m0, int n0, int mh) {
  const int lane = tidx() & 63, wid = tidx() >> 6;
  WavePos w; w.nb = n0 + (wid >> 1) * 64; w.mb = m0 + (wid & 1) * 128 + mh * 64; w.fr = lane & 15; w.fq = lane >> 4; return w;
}

__device__ __forceinline__ void store_all(u16* C, int ldc, int c0, const WavePos& w, f32x4 (&acc)[4][4]) {
#pragma unroll
  for (int mi = 0; mi < 4; ++mi) {
    u16* rp = C + (size_t)(w.mb + mi * 16 + w.fr) * ldc + c0 + w.fq * 4;
#pragma unroll
    for (int ni = 0; ni < 4; ++ni) st4bf(rp + ni * 16, acc[ni][mi]);
  }
}
__device__ __forceinline__ void store_all_tiled(u16* C, int K, int c0, const WavePos& w, f32x4 (&acc)[4][4]) {
#pragma unroll
  for (int mi = 0; mi < 4; ++mi) {
    const int m = w.mb + mi * 16 + w.fr;
#pragma unroll
    for (int ni = 0; ni < 4; ++ni) st4bf(C + tiled_off(m, c0 + ni * 16 + w.fq * 4, K), acc[ni][mi]);
  }
}
__device__ __forceinline__ void store_ctx_f32(float* outb, int ncols, int c0, int l, const WavePos& w, f32x4 (&acc)[4][4], int nimax) {
#pragma unroll
  for (int mi = 0; mi < 4; ++mi) {
    const int m = w.mb + mi * 16 + w.fr, b = m >> 8, s = m & 255;
    float* rp = outb + ((size_t)((b * 4 + l) * 256 + s)) * ncols + c0 + w.fq * 4;
#pragma unroll
    for (int ni = 0; ni < 4; ++ni) if (ni < nimax) *(float4*)(rp + ni * 16) = make_float4(acc[ni][mi][0], acc[ni][mi][1], acc[ni][mi][2], acc[ni][mi][3]);
  }
}
__device__ __forceinline__ void store_vt(u16* VT, int NH, int head, const WavePos& w, f32x4 (&acc)[4][4]) {
#pragma unroll
  for (int mi = 0; mi < 4; ++mi) {
    const int m = w.mb + mi * 16 + w.fr;
    u16* bp; size_t stride;
    if (m < MCTX) { const int b = m >> 8, s = m & 255; bp = VT + ((size_t)(b * NH + head) * 64) * 256 + s; stride = 256; }
    else { const int ml = m - MCTX, b = ml >> 12, t = ml & 4095; bp = VT + (size_t)MCTX * NH * 64 + ((size_t)(b * NH + head) * 64) * 4096 + t; stride = 4096; }
#pragma unroll
    for (int ni = 0; ni < 4; ++ni)
#pragma unroll
      for (int j = 0; j < 4; ++j) {
        const int d = ni * 16 + w.fq * 4 + j;
        bp[(size_t)d * stride] = (u16)(pk2(acc[ni][mi][j], 0.f) & 0xffffu);
      }
  }
}
__device__ __forceinline__ void rope64(const WavePos& w, f32x4 (&acc)[4][4]) {
  float inv[4];
#pragma unroll
  for (int j = 0; j < 4; ++j) inv[j] = exp2f(-(float)(w.fq * 4 + j) * (L2THETA / 16.f));
#pragma unroll
  for (int mi = 0; mi < 4; ++mi) {
    const int t = (w.mb + mi * 16 + w.fr - MCTX) & 4095;
    const float pr = (float)(t >> 6), pc = (float)(t & 63);
#pragma unroll
    for (int hf = 0; hf < 2; ++hf) {
      const float pos = hf ? pc : pr;
#pragma unroll
      for (int j = 0; j < 4; ++j) {
        const float a = pos * inv[j], sn = __sinf(a), cs = __cosf(a);
        const float x1 = acc[2 * hf][mi][j], x2 = acc[2 * hf + 1][mi][j];
        acc[2 * hf][mi][j] = x1 * cs - x2 * sn;
        acc[2 * hf + 1][mi][j] = x2 * cs + x1 * sn;
      }
    }
  }
}
__device__ __forceinline__ void rope32(const WavePos& w, f32x4 (&acc)[4][4], int nimax) {
  float inv[4];
#pragma unroll
  for (int j = 0; j < 4; ++j) inv[j] = exp2f(-(float)((w.fq & 1) * 4 + j) * (L2THETA / 8.f));
  const bool second = w.fq >= 2;
#pragma unroll
  for (int mi = 0; mi < 4; ++mi) {
    const int t = (w.mb + mi * 16 + w.fr - MCTX) & 4095;
    const float pr = (float)(t >> 6), pc = (float)(t & 63);
#pragma unroll
    for (int ni = 0; ni < 4; ++ni) {
      if (ni < nimax) {
        const float pos = (ni & 1) ? pc : pr;
#pragma unroll
        for (int j = 0; j < 4; ++j) {
          const float a = pos * inv[j], sn = __sinf(a), cs = __cosf(a);
          const float x = acc[ni][mi][j], o = __shfl_xor(x, 32);
          acc[ni][mi][j] = second ? (x * cs + o * sn) : (x * cs - o * sn);
        }
      }
    }
  }
}
__device__ __forceinline__ void row_ssq(f32x4 (&acc)[4][4], float (&ss)[4]) {
#pragma unroll
  for (int mi = 0; mi < 4; ++mi) {
    float s = 0.f;
#pragma unroll
    for (int ni = 0; ni < 4; ++ni)
#pragma unroll
      for (int j = 0; j < 4; ++j) s += acc[ni][mi][j] * acc[ni][mi][j];
    s += __shfl_xor(s, 16);
    s += __shfl_xor(s, 32);
    ss[mi] = s;
  }
}
__device__ __forceinline__ void head_norm(const WavePos& w, f32x4 (&acc)[4][4], const float* g) {
  float ss[4];
  row_ssq(acc, ss);
#pragma unroll
  for (int ni = 0; ni < 4; ++ni) {
    const float4 gv = *(const float4*)(g + ni * 16 + w.fq * 4);
#pragma unroll
    for (int mi = 0; mi < 4; ++mi) {
      const float r = rsqrtf(ss[mi] * (1.f / 64.f) + EPS);
      acc[ni][mi][0] *= r * gv.x; acc[ni][mi][1] *= r * gv.y; acc[ni][mi][2] *= r * gv.z; acc[ni][mi][3] *= r * gv.w;
    }
  }
}
__device__ __forceinline__ void ssq_atomic(const WavePos& w, f32x4 (&acc)[4][4], float* ssq) {
  float ss[4];
  row_ssq(acc, ss);
  if (w.fq == 0) {
#pragma unroll
    for (int mi = 0; mi < 4; ++mi) atomicAdd(ssq + w.mb + mi * 16 + w.fr, ss[mi]);
  }
}

__device__ __forceinline__ void scale_acc(f32x4 (&acc)[4][4], float f) {
#pragma unroll
  for (int ni = 0; ni < 4; ++ni)
#pragma unroll
    for (int mi = 0; mi < 4; ++mi) acc[ni][mi] *= f;
}
__device__ __forceinline__ void epi_win(const Params& P, int l, const WavePos& w, f32x4 (&acc)[4][4], bool do_atomic = true) {
  unsigned char* ws = P.ws;
  const bool lat = w.mb >= MCTX;
  const int nb = w.nb;
  float* ssq = (float*)(ws + W_SSQ) + (size_t)l * 2 * MT;
  if (nb < 512) { if (lat) rope64(w, acc); scale_acc(acc, QSC_AC); store_all_tiled((u16*)(ws + W_QA), 512, nb, w, acc); }
  else if (nb < 640) {
    if (!lat) store_ctx_f32(P.out + O_NAK, 128, nb - 512, l, w, acc, 4); else rope64(w, acc);
    store_all((u16*)(ws + W_KA), 128, nb - 512, w, acc);
  } else if (nb < 768) {
    if (!lat) store_ctx_f32(P.out + O_NAV, 128, nb - 640, l, w, acc, 4);
    store_vt((u16*)(ws + W_VAT), 2, (nb - 640) >> 6, w, acc);
  } else if (nb < 1152) { store_all((u16*)(ws + W_QBD), 384, nb - 768, w, acc); if (do_atomic) ssq_atomic(w, acc, ssq); }
  else if (nb < 1408) {
    store_all((u16*)(ws + W_KVBD), 256, nb - 1152, w, acc); if (do_atomic) ssq_atomic(w, acc, ssq + MT);
    if (!lat) store_ctx_f32(P.out + O_NCKV, 256, nb - 1152, l, w, acc, 4);
  } else if (nb < 1920) { head_norm(w, acc, P.in[I_GQC] + l * 64); if (lat) rope64(w, acc); scale_acc(acc, QSC_AC); store_all_tiled((u16*)(ws + W_QC), 512, nb - 1408, w, acc); }
  else if (nb < 2048) {
    head_norm(w, acc, P.in[I_GKC] + l * 64);
    if (!lat) store_ctx_f32(P.out + O_NCK, 128, nb - 1920, l, w, acc, 4); else rope64(w, acc);
    store_all((u16*)(ws + W_KC), 128, nb - 1920, w, acc);
  } else if (nb < 2176) {
    if (!lat) store_ctx_f32(P.out + O_NCV, 128, nb - 2048, l, w, acc, 4);
    store_vt((u16*)(ws + W_VCT), 2, (nb - 2048) >> 6, w, acc);
  } else if (nb < 5248) {
#pragma unroll
    for (int ni = 0; ni < 4; ++ni)
#pragma unroll
      for (int mi = 0; mi < 4; ++mi)
#pragma unroll
        for (int j = 0; j < 4; ++j) acc[ni][mi][j] = __builtin_amdgcn_rcpf(1.f + __builtin_amdgcn_exp2f(-LOG2E * acc[ni][mi][j]));
    store_all((u16*)(ws + W_GATES), 3072, nb - 2176, w, acc);
  } else if (nb == 5248) {
    if (!lat) store_ctx_f32(P.out + O_NKR, 32, 0, l, w, acc, 2); else rope32(w, acc, 2);
    u16* KR = (u16*)(ws + W_KR);
#pragma unroll
    for (int mi = 0; mi < 4; ++mi) {
      u16* rp = KR + (size_t)(w.mb + mi * 16 + w.fr) * 32 + w.fq * 4;
      st4bf(rp, acc[0][mi]); st4bf(rp + 16, acc[1][mi]);
    }
  }
}


template <int MIX>
__device__ __forceinline__ void attn_unit(const Params& P, int l, bool lat, int b, int h, int qb, char* smem, bool dummy) {
  unsigned char* ws = P.ws;
  const int tid = tidx(), lane = tid & 63, wv = tid >> 6, r = lane & 31, hh = lane >> 5;
  constexpr int NS = (MIX == 1) ? 6 : 4;
  const int g = h >> 2;
  const int rq0 = lat ? MCTX + b * 4096 + qb * 128 : b * 256 + qb * 128;
  const int qrow = rq0 + wv * 32 + r;
  u16* qbase; int qld;
  if (MIX == 0) { qbase = (u16*)(ws + W_QA); qld = 512; } else if (MIX == 1) { qbase = (u16*)(ws + W_QB); qld = 768; } else { qbase = (u16*)(ws + W_QC); qld = 512; }
  bf16x8 qf[NS];
  {
#pragma unroll
    for (int s = 0; s < 4; ++s) qf[s] = *(const bf16x8*)(qbase + tiled_off(qrow, h * 64 + s * 16 + hh * 8, qld));
    if (MIX == 1) {
#pragma unroll
      for (int s = 4; s < NS; ++s) qf[s] = *(const bf16x8*)(qbase + tiled_off(qrow, 512 + h * 32 + (s - 4) * 16 + hh * 8, qld));
    }
  }
  constexpr int KST = (MIX == 1) ? 512 : 128;
  const u16 *K0, *K1, *R0 = nullptr, *R1p = nullptr, *V0, *V1;
  int vs0, vs1, nt0, nt1, pos1 = 0;
  if (!lat) {
    const int r0 = b * 256;
    if (MIX == 0) { K0 = (const u16*)(ws + W_KA) + (size_t)r0 * 128 + g * 64; V0 = (const u16*)(ws + W_VAT) + ((size_t)(b * 2 + g) * 64) * 256; }
    else if (MIX == 1) { K0 = (const u16*)(ws + W_KBN) + (size_t)r0 * 512 + h * 64; R0 = (const u16*)(ws + W_KR) + (size_t)r0 * 32; V0 = (const u16*)(ws + W_VBT) + ((size_t)(b * 8 + h) * 64) * 256; }
    else { K0 = (const u16*)(ws + W_KC) + (size_t)r0 * 128 + g * 64; V0 = (const u16*)(ws + W_VCT) + ((size_t)(b * 2 + g) * 64) * 256; }
    vs0 = 256; nt0 = 4;
    K1 = K0; R1p = R0; V1 = V0; vs1 = 256; nt1 = 0;
  } else {
    const int c0 = b * 512;
    int k0 = 0, k1 = 4096;
    if (MIX == 0) { k0 = (qb > 0 ? qb - 1 : 0) * 128; k1 = (qb + 2 < 32 ? qb + 2 : 32) * 128; }
    const int r0 = MCTX + b * 4096 + k0;
    if (MIX == 0) {
      K0 = (const u16*)(ws + W_KCA) + (size_t)c0 * 128 + g * 64; V0 = (const u16*)(ws + W_VCAT) + ((size_t)(b * 2 + g) * 64) * 512;
      K1 = (const u16*)(ws + W_KA) + (size_t)r0 * 128 + g * 64;
      V1 = (const u16*)(ws + W_VAT) + (size_t)MCTX * 128 + ((size_t)(b * 2 + g) * 64) * 4096 + k0;
    } else if (MIX == 1) {
      K0 = (const u16*)(ws + W_KBNC) + (size_t)c0 * 512 + h * 64; R0 = (const u16*)(ws + W_KRC) + (size_t)c0 * 32; V0 = (const u16*)(ws + W_VBTC) + ((size_t)(b * 8 + h) * 64) * 512;
      K1 = (const u16*)(ws + W_KBN) + (size_t)r0 * 512 + h * 64; R1p = (const u16*)(ws + W_KR) + (size_t)r0 * 32;
      V1 = (const u16*)(ws + W_VBT) + (size_t)MCTX * 512 + ((size_t)(b * 8 + h) * 64) * 4096 + k0;
    } else {
      K0 = (const u16*)(ws + W_KCC) + (size_t)c0 * 128 + g * 64; V0 = (const u16*)(ws + W_VCCT) + ((size_t)(b * 2 + g) * 64) * 512;
      K1 = (const u16*)(ws + W_KC) + (size_t)r0 * 128 + g * 64;
      V1 = (const u16*)(ws + W_VCT) + (size_t)MCTX * 128 + ((size_t)(b * 2 + g) * 64) * 4096 + k0;
    }
    vs0 = 512; nt0 = 8; vs1 = 4096; nt1 = (k1 - k0) >> 6; pos1 = k0;
  }
  const int ntot = nt0 + nt1;

  float m_run = -1e30f, l_run = 0.f;
  if (MIX == 0) { m_run = P.in[I_SINK][l * 8 + h] * LOG2E; l_run = (hh == 0) ? 1.f : 0.f; }
  f32x16 o0, o1, mref;
#pragma unroll
  for (int i = 0; i < 16; ++i) { o0[i] = 0.f; o1[i] = 0.f; mref[i] = 0.f; }

  const int krow = wv * 8 + (lane >> 3);
  const int kch = (lane & 7) ^ (((lane >> 4) + 4 * (wv & 1)) & 7);
  const int rrow = wv * 16 + (lane >> 2), rch = (lane & 3) ^ ((lane >> 4) & 3);
  char* dl = smem + wv * 1024 + lane * 16;
  const u16* kq = K0 + (size_t)krow * KST + kch * 8;
  const u16* vq = V0 + (size_t)krow * vs0 + kch * 8;
  const u16* rq = (MIX == 1) ? R0 + (size_t)rrow * 32 + rch * 8 : nullptr;
  int vhi = 32 * vs0, nreq = 0, slot_off = 0;
  auto issue = [&](int) {
    char* d = dl + slot_off;
    __builtin_amdgcn_global_load_lds(kq, LDS_PTR(d), 16, 0, 0);
    __builtin_amdgcn_global_load_lds(kq + 32 * KST, LDS_PTR(d + 4096), 16, 0, 0);
    __builtin_amdgcn_global_load_lds(vq, LDS_PTR(d + 12288), 16, 0, 0);
    __builtin_amdgcn_global_load_lds(vq + vhi, LDS_PTR(d + 12288 + 4096), 16, 0, 0);
    if (MIX == 1) __builtin_amdgcn_global_load_lds(rq, LDS_PTR(d + 8192), 16, 0, 0);
    kq += 64 * KST; vq += 64; if (MIX == 1) rq += 64 * 32;
    slot_off = (slot_off == 40960) ? 0 : slot_off + 20480;
    if (++nreq == nt0) {
      kq = K1 + (size_t)krow * KST + kch * 8;
      vq = V1 + (size_t)krow * vs1 + kch * 8;
      if (MIX == 1) rq = R1p + (size_t)rrow * 32 + rch * 8;
      vhi = 32 * vs1;
    }
  };
  const int keyr = (r & 0x13) | ((r & 4) << 1) | ((r & 8) >> 1);
  const int qpos = qb * 128 + wv * 32 + r;

#pragma unroll
  for (int s = 0; s < NS; ++s) asm volatile("" :: "v"(qf[s]));
  asm volatile("s_waitcnt vmcnt(0)" ::: "memory");
  __builtin_amdgcn_s_barrier();
  issue(0);
  issue(1);
  int rcur = 0;
  for (int ti = 0; ti < ntot; ++ti) {
    if (ti + 1 < ntot) { if (MIX == 1) asm volatile("s_waitcnt vmcnt(5)" ::: "memory"); else asm volatile("s_waitcnt vmcnt(4)" ::: "memory"); }
    else asm volatile("s_waitcnt vmcnt(0)" ::: "memory");
    __builtin_amdgcn_s_barrier();
    asm volatile("" ::: "memory");
    if (ti + 2 < ntot && !(PROBE_VAR == 2 && dummy)) issue(ti + 2);
    const int cur = rcur;
    rcur = (rcur == 40960) ? 0 : rcur + 20480;
    bf16x8 kf[2 * NS], vf[8];
#pragma unroll
    for (int s = 0; s < NS; ++s) {
#pragma unroll
      for (int kt2 = 0; kt2 < 2; ++kt2) {
        const int key = kt2 * 32 + keyr;
        int addr;
        if (s < 4) addr = cur + key * 128 + (((s * 2 + hh) ^ ((key >> 1) & 7)) << 4);
        else addr = cur + 8192 + key * 64 + ((((s - 4) * 2 + hh) ^ ((key >> 2) & 3)) << 4);
        kf[2 * s + kt2] = *(const bf16x8*)(smem + addr);
      }
    }
#pragma unroll
    for (int ks = 0; ks < 4; ++ks) {
#pragma unroll
      for (int dt = 0; dt < 2; ++dt) {
        const int d = dt * 32 + r;
        vf[2 * ks + dt] = *(const bf16x8*)(smem + cur + 12288 + d * 128 + (((ks * 2 + hh) ^ ((d >> 1) & 7)) << 4));
      }
    }
    f32x16 s0, s1;
    s0 = __builtin_amdgcn_mfma_f32_32x32x16_bf16(kf[0], qf[0], mref, 0, 0, 0);
    s1 = __builtin_amdgcn_mfma_f32_32x32x16_bf16(kf[1], qf[0], mref, 0, 0, 0);
#pragma unroll
    for (int s = 1; s < NS; ++s) {
      s0 = __builtin_amdgcn_mfma_f32_32x32x16_bf16(kf[2 * s], qf[s], s0, 0, 0, 0);
      s1 = __builtin_amdgcn_mfma_f32_32x32x16_bf16(kf[2 * s + 1], qf[s], s1, 0, 0, 0);
    }
    if (MIX == 0 && ti >= nt0) {
      const int kb = pos1 + (ti - nt0) * 64;
      const int qw = qb * 128 + __builtin_amdgcn_readfirstlane(wv) * 32;
      const bool inside = (kb + 63 - qw <= 128) && (qw + 31 - kb <= 128);
      const int kp0 = kb + 8 * hh;
      if (!inside) {
#pragma unroll
      for (int i = 0; i < 16; ++i) {
        const int ko = 16 * (i >> 3) + (i & 7);
        int d0 = qpos - (kp0 + ko); d0 = d0 < 0 ? -d0 : d0;
        int d1 = qpos - (kp0 + 32 + ko); d1 = d1 < 0 ? -d1 : d1;
        if (d0 > 128) s0[i] = -1e30f;
        if (d1 > 128) s1[i] = -1e30f;
      }
      }
    }
    if (ti == 0) {
      float mx = s0[0];
#pragma unroll
      for (int i = 1; i < 16; ++i) mx = fmaxf(mx, s0[i]);
#pragma unroll
      for (int i = 0; i < 16; ++i) mx = fmaxf(mx, s1[i]);
      mx = fmaxf(mx, __shfl_xor(mx, 32));
      const float m_new = fmaxf(m_run, mx);
      l_run *= __builtin_amdgcn_exp2f(m_run - m_new);
      m_run = m_new;
#pragma unroll
      for (int i = 0; i < 16; ++i) { s0[i] -= m_new; s1[i] -= m_new; mref[i] = -m_new; }
    }
    f32x2_t ps2 = {0.f, 0.f};
#pragma unroll
    for (int i = 0; i < 16; i += 2) {
      f32x2_t v = {__builtin_amdgcn_exp2f(s0[i]), __builtin_amdgcn_exp2f(s0[i + 1])};
      ps2 += v; s0[i] = v[0]; s0[i + 1] = v[1];
    }
#pragma unroll
    for (int i = 0; i < 16; i += 2) {
      f32x2_t v = {__builtin_amdgcn_exp2f(s1[i]), __builtin_amdgcn_exp2f(s1[i + 1])};
      ps2 += v; s1[i] = v[0]; s1[i + 1] = v[1];
    }
    float psum = ps2[0] + ps2[1];
    if (__builtin_amdgcn_ballot_w64(psum > 4096.f) != 0ull) {
      float pm = s0[0];
#pragma unroll
      for (int i = 1; i < 16; ++i) pm = fmaxf(pm, s0[i]);
#pragma unroll
      for (int i = 0; i < 16; ++i) pm = fmaxf(pm, s1[i]);
      pm = fmaxf(fmaxf(pm, __shfl_xor(pm, 32)), 1.f);
      const float f = 1.f / pm;
      m_run += __builtin_amdgcn_logf(pm);
#pragma unroll
      for (int i = 0; i < 16; ++i) mref[i] = -m_run;
      psum *= f; l_run *= f;
#pragma unroll
      for (int i = 0; i < 16; ++i) { s0[i] *= f; s1[i] *= f; o0[i] *= f; o1[i] *= f; }
    }
    l_run += psum;
    bf16x8 pb[4];
#pragma unroll
    for (int u = 0; u < 2; ++u) {
      union { bf16x8 v; unsigned w[4]; } t0, t1;
#pragma unroll
      for (int j = 0; j < 4; ++j) { t0.w[j] = pk2(s0[8 * u + 2 * j], s0[8 * u + 2 * j + 1]); t1.w[j] = pk2(s1[8 * u + 2 * j], s1[8 * u + 2 * j + 1]); }
      pb[u] = t0.v; pb[2 + u] = t1.v;
    }
#pragma unroll
    for (int ks = 0; ks < 4; ++ks) {
#pragma unroll
      for (int dt = 0; dt < 2; ++dt) {
        if (dt == 0) o0 = __builtin_amdgcn_mfma_f32_32x32x16_bf16(vf[2 * ks], pb[ks], o0, 0, 0, 0);
        else o1 = __builtin_amdgcn_mfma_f32_32x32x16_bf16(vf[2 * ks + 1], pb[ks], o1, 0, 0, 0);
      }
    }
  }
  const float lt = l_run + __shfl_xor(l_run, 32);
  const float inv = 1.f / lt;
  u16* ob = dummy ? (u16*)(ws + W_H) : qbase;
#pragma unroll
  for (int i4 = 0; i4 < 4; ++i4) {
    f32x4 a = {o0[4 * i4] * inv, o0[4 * i4 + 1] * inv, o0[4 * i4 + 2] * inv, o0[4 * i4 + 3] * inv};
    f32x4 c = {o1[4 * i4] * inv, o1[4 * i4 + 1] * inv, o1[4 * i4 + 2] * inv, o1[4 * i4 + 3] * inv};
    st4bf(ob + tiled_off(qrow, h * 64 + 4 * hh + 8 * i4, qld), a);
    st4bf(ob + tiled_off(qrow, h * 64 + 32 + 4 * hh + 8 * i4, qld), c);
  }
}

__device__ __forceinline__ void attn_phase(const Params& P, int l, char* smem, bool dummy) {
  for (int i = blockIdx.x; i < 4608; i += gridDim.x) {
    int grp, b, h, qb; bool lat;
    if (i < 3072) {
      const int j = i & 1023, jp = (j & 7) * 128 + (j >> 3);
      grp = i >> 10; lat = true; b = jp >> 8; h = (jp >> 5) & 7; qb = jp & 31;
    } else {
      const int k = i - 3072, j = k & 511, jp = (j & 7) * 64 + (j >> 3);
      grp = k >> 9; lat = false; b = jp >> 4; h = (jp >> 1) & 7; qb = jp & 1;
    }
    if (grp == 0) attn_unit<1>(P, l, lat, b, h, qb, smem, dummy);
    else if (grp == 1) attn_unit<2>(P, l, lat, b, h, qb, smem, dummy);
    else attn_unit<0>(P, l, lat, b, h, qb, smem, dummy);
  }
}


#define XB_TMO      128
#define XB_XCNT(j)  (256  + 64 * (j))
#define XB_XSUB(j)  (1280 + 64 * (j))
#define XB_XGEN(j)  (2304 + 64 * (j))
#define XB_TOP      3328
#define XB_TOPGEN   3392
#define XCD_BAR_WORDS 3456
#define XB_SPIN_CAP (1u << 20)
__device__ __forceinline__ unsigned xb_ld(unsigned* p) { return __hip_atomic_load(p, __ATOMIC_RELAXED, __HIP_MEMORY_SCOPE_AGENT); }
__device__ __forceinline__ unsigned xb_add(unsigned* p, unsigned v) { return __hip_atomic_fetch_add(p, v, __ATOMIC_RELAXED, __HIP_MEMORY_SCOPE_AGENT); }
__device__ __forceinline__ unsigned xb_xcc_id() { return (unsigned)__builtin_amdgcn_s_getreg((3 << 11) | 20) & 0xFu; }
#define XB_SPIN(cond, bar) do { unsigned _sp = 0; while (cond) { __builtin_amdgcn_s_sleep(1); \
    if ((++_sp & 255u) == 0u) { if (xb_ld(&(bar)[XB_TMO])) break; if (_sp > XB_SPIN_CAP) { atomicAdd(&(bar)[XB_TMO], 1u); break; } } } } while (0)
__device__ __forceinline__ void xcd_barrier_complete(unsigned* bar, unsigned x, unsigned& nloc, unsigned& nx) {
  const unsigned G = gridDim.x;
  unsigned sum, cnt, mine, sp = 0u;
  for (;;) {
    sum = 0u; cnt = 0u; mine = 0u;
#pragma unroll
    for (unsigned j = 0; j < 16; ++j) { const unsigned c = xb_ld(&bar[XB_XCNT(j)]); sum += c; cnt += (c > 0u) ? 1u : 0u; mine = (j == x) ? c : mine; }
    if (sum == G) break;
    __builtin_amdgcn_s_sleep(1);
    if ((++sp & 255u) == 0u) { if (xb_ld(&bar[XB_TMO])) break; if (sp > XB_SPIN_CAP) { atomicAdd(&bar[XB_TMO], 1u); break; } }
  }
  nloc = mine > 0u ? mine : 1u; nx = cnt > 0u ? cnt : 1u;
}
__device__ __forceinline__ void xcd_barrier(unsigned* bar, unsigned x, unsigned& nloc, unsigned& nx) {
  asm volatile("s_waitcnt vmcnt(0)" ::: "memory");
  __syncthreads();
  if (threadIdx.x == 0) {
    __builtin_amdgcn_s_waitcnt(0);
    if (nloc == 0u) xcd_barrier_complete(bar, x, nloc, nx);
    const unsigned old = xb_add(&bar[XB_XSUB(x)], 1u);
    const unsigned gen = old / nloc;
    if (old + 1u == (gen + 1u) * nloc) {
      __builtin_amdgcn_fence(__ATOMIC_RELEASE, "agent");
      asm volatile("s_waitcnt vmcnt(0)" ::: "memory");
      const unsigned og = xb_add(&bar[XB_TOP], 1u);
      const unsigned tg = og / nx;
      if (og + 1u == (tg + 1u) * nx) xb_add(&bar[XB_TOPGEN], 1u);
      else XB_SPIN(xb_ld(&bar[XB_TOPGEN]) == tg, bar);
      __builtin_amdgcn_fence(__ATOMIC_ACQUIRE, "agent");
      xb_add(&bar[XB_XGEN(x)], 1u);
      asm volatile("s_waitcnt vmcnt(0)" ::: "memory");
    } else {
      XB_SPIN(xb_ld(&bar[XB_XGEN(x)]) == gen, bar);
      __builtin_amdgcn_fence(__ATOMIC_ACQUIRE, "agent");
      asm volatile("s_waitcnt vmcnt(0)" ::: "memory");
    }
  }
  __syncthreads();
}

constexpr int NPHASE = 2 + 9 * DEPTH;
constexpr int LDS_BYTES = 73728;

__global__ void __launch_bounds__(256, 2) fwd_kernel(Params PA, int ph_lo, int ph_hi) {
  extern __shared__ __attribute__((aligned(16))) char smem[];
  const Params& P = PA;
  unsigned char* ws = P.ws;
#if MK_COOP
  unsigned* bar = (unsigned*)(ws + W_BAR);
  const unsigned xb_x = xb_xcc_id();
  unsigned xb_nloc = 0u, xb_nx = 0u;
  if (threadIdx.x == 0) (void)xb_add(&bar[XB_XCNT(xb_x)], 1u);
#endif
  for (int ph = ph_lo; ph < ph_hi; ++ph) {
    if (ph == 0) {
      const int nitems = 384 + 192 + CONV_ITEMS;
      for (int it = blockIdx.x; it < nitems; it += gridDim.x) {
        if (it < 384) mod_item(P, it, smem);
        else if (it < 576) { float4* z = (float4*)(ws + W_SSQ) + (size_t)(it - 384) * 256 + tidx(); *z = make_float4(0.f, 0.f, 0.f, 0.f); }
        else convert_item(P, 0, it - 576, smem);
      }
    } else if (ph == 1) {
#if PROBE_DUP == 1
      rows_phase(P, 0, 0);
      xcd_barrier(bar, xb_x, xb_nloc, xb_nx);
      for (int it = blockIdx.x; it < CONV_ITEMS; it += gridDim.x) convert_item(P, 0, it, smem);
      xcd_barrier(bar, xb_x, xb_nloc, xb_nx);
#endif
      rows_phase(P, 0, 0);
    } else {
      const int l = (ph - 2) / 9, sub = (ph - 2) % 9;
#if PROBE_SUB >= 0
      for (int prep = 0; prep < ((sub == PROBE_SUB) ? 2 : 1); ++prep) {
      if (prep) xcd_barrier(bar, xb_x, xb_nloc, xb_nx);
#endif
      if (sub == 0) {
        constexpr int NTN = NINP / 128, T = (MT / 256) * NTN;
        gemm_phase_big<true, true>((const u16*)(ws + W_H), 1024, (const u16*)(ws + W_WIN), 1024, T, NTN, smem,
          [&](int m0, int n0, f32x4 (&acc)[2][4][4]) {
#pragma unroll
            for (int mh = 0; mh < 2; ++mh) { const WavePos w = wave_pos_big(m0, n0, mh); epi_win(P, l, w, acc[mh], PROBE_FIRST); }
          });
      } else if (sub == 1) {
        constexpr int T0 = 192 * 6, T1 = 192 * 8, T2 = 16 * 8;
        const float* ssq = (const float*)(ws + W_SSQ) + (size_t)l * 2 * MT;
        for (int t = blockIdx.x; t < T0 + T1 + T2; t += gridDim.x) {
          f32x4 acc[4][4]; zero_acc(acc);
          int kind, mt, nt, K; const u16 *X, *W;
          if (t < T0) { kind = 0; tile_map(t, T0, 6, mt, nt); X = (const u16*)(ws + W_QBD); W = (const u16*)(ws + W_WQ); K = 384; }
          else if (t < T0 + T1) { kind = 1; tile_map(t - T0, T1, 8, mt, nt); X = (const u16*)(ws + W_KVBD); W = (const u16*)(ws + W_WKV); K = 256; }
          else { kind = 2; const int tt = t - T0 - T1; mt = tt >> 3; nt = tt & 7; X = (const u16*)(ws + W_CKVC); W = (const u16*)(ws + W_WKVC); K = 256; }
          gemm_core<false, false>(X, K, W, K, mt * 128, nt * 128, smem, acc);
          const WavePos w = wave_pos(mt * 128, nt * 128);
          if (kind < 2) {
            const float* sq = ssq + (kind ? MT : 0);
            const float rk = kind ? (1.f / 256.f) : (1.f / 384.f);
            const float qs = kind ? 1.f : QSC_B;
#pragma unroll
            for (int mi = 0; mi < 4; ++mi) {
              const float rs = rsqrtf(sq[w.mb + mi * 16 + w.fr] * rk + EPS) * qs;
#pragma unroll
              for (int ni = 0; ni < 4; ++ni) acc[ni][mi] *= rs;
            }
          }
          if (kind == 0) {
            if (w.mb >= MCTX && w.nb >= 512) rope32(w, acc, 4);
            store_all_tiled((u16*)(ws + W_QB), 768, w.nb, w, acc);
          } else if (w.nb < 512) {
            store_all((u16*)(ws + (kind == 1 ? W_KBN : W_KBNC)), 512, w.nb, w, acc);
          } else if (kind == 1) {
            store_vt((u16*)(ws + W_VBT), 8, (w.nb - 512) >> 6, w, acc);
          } else {
            u16* VT = (u16*)(ws + W_VBTC);
            const int head = (w.nb - 512) >> 6;
#pragma unroll
            for (int mi = 0; mi < 4; ++mi) {
              const int m = w.mb + mi * 16 + w.fr, b = m >> 9, s = m & 511;
              u16* bp = VT + ((size_t)(b * 8 + head) * 64) * 512 + s;
#pragma unroll
              for (int ni = 0; ni < 4; ++ni)
#pragma unroll
                for (int j = 0; j < 4; ++j) bp[(size_t)(ni * 16 + w.fq * 4 + j) * 512] = (u16)(pk2(acc[ni][mi][j], 0.f) & 0xffffu);
            }
          }
        }
        {
          const int lane = tidx() & 63, gw = blockIdx.x * 4 + (tidx() >> 6), nw = gridDim.x * 4;
          const float4 g = *(const float4*)(P.in[I_GKVA] + l * 256 + lane * 4);
          for (int m = gw; m < MCTX; m += nw) {
            const float rs = rsqrtf(ssq[MT + m] * (1.f / 256.f) + EPS);
            float4* p = (float4*)(P.out + O_NCKV + ((size_t)(((m >> 8) * 4 + l) * 256 + (m & 255))) * 256 + lane * 4);
            float4 v = *p;
            v.x *= rs * g.x; v.y *= rs * g.y; v.z *= rs * g.z; v.w *= rs * g.w;
            *p = v;
          }
        }
      } else if (sub == 2) {
#if PROBE_DUP == 2
        attn_phase(P, l, smem, true);
        xcd_barrier(bar, xb_x, xb_nloc, xb_nx);
#endif
        attn_phase(P, l, smem, false);
      } else if (sub == 3) {
        constexpr int T = 192 * 8;
        const u16* G = (const u16*)(ws + W_GATES);
        for (int t = blockIdx.x; t < T; t += gridDim.x) {
          int mt, nt; tile_map(t, T, 8, mt, nt);
          const WavePos w = wave_pos(mt * 128, nt * 128);
          f32x4 tot[4][4]; zero_acc(tot);
#pragma unroll 1
          for (int br = 0; br < 3; ++br) {
            f32x4 acc[4][4]; zero_acc(acc);
            const u16* A = br == 0 ? (const u16*)(ws + W_QA) : (br == 1 ? (const u16*)(ws + W_QB) : (const u16*)(ws + W_QC));
            gemm_core<true, true>(A, br == 1 ? 768 : 512, (const u16*)(ws + W_WO3) + (size_t)br * 1024 * 512, 512, mt * 128, nt * 128, smem, acc);
#pragma unroll
            for (int mi = 0; mi < 4; ++mi) {
              const u16* gp = G + (size_t)(w.mb + mi * 16 + w.fr) * 3072 + br * 1024 + w.nb + w.fq * 4;
#pragma unroll
              for (int ni = 0; ni < 4; ++ni) {
                const uint2 gb = *(const uint2*)(gp + ni * 16);
                tot[ni][mi][0] += bflo(gb.x) * acc[ni][mi][0]; tot[ni][mi][1] += bfhi(gb.x) * acc[ni][mi][1];
                tot[ni][mi][2] += bflo(gb.y) * acc[ni][mi][2]; tot[ni][mi][3] += bfhi(gb.y) * acc[ni][mi][3];
              }
            }
          }
          store_all_tiled((u16*)(ws + W_MBUF), 1024, w.nb, w, tot);
        }
      } else if (sub == 4) {
        constexpr int T = 192 * 8;
        for (int t = blockIdx.x; t < T; t += gridDim.x) {
          int mt, nt; tile_map(t, T, 8, mt, nt);
          f32x4 acc[4][4]; zero_acc(acc);
          gemm_core<true, true>((const u16*)(ws + W_MBUF), 1024, (const u16*)(ws + W_WOUT), 1024, mt * 128, nt * 128, smem, acc);
          const WavePos w = wave_pos(mt * 128, nt * 128);
          store_all((u16*)(ws + W_T), 1024, w.nb, w, acc);
        }
      } else if (sub == 5) {
        rows_phase(P, 1, l);
      } else if (sub == 6) {
        constexpr int T = 96 * 32;
#if PROBE_DUP == 6
        for (int rep = 0; rep < 2; ++rep) {
        if (rep) xcd_barrier(bar, xb_x, xb_nloc, xb_nx);
#endif
        gemm_phase_big<true, true>((const u16*)(ws + W_H), 1024, (const u16*)(ws + W_W1), 1024, T, 32, smem,
          [&](int m0, int n0, f32x4 (&acc)[2][4][4]) {
#pragma unroll
            for (int mh = 0; mh < 2; ++mh) {
              const WavePos w = wave_pos_big(m0, n0, mh);
#pragma unroll
              for (int ni = 0; ni < 4; ++ni)
#pragma unroll
                for (int mi = 0; mi < 4; ++mi)
#pragma unroll
                  for (int j = 0; j < 4; ++j) { const float v = fmaxf(acc[mh][ni][mi][j], 0.f); acc[mh][ni][mi][j] = v * v; }
              store_all_tiled((u16*)(ws + W_U), 4096, w.nb, w, acc[mh]);
            }
          });
#if PROBE_DUP == 6
        }
#endif
      } else if (sub == 7) {
        constexpr int T = 192 * 8;
        for (int t = blockIdx.x; t < T; t += gridDim.x) {
          int mt, nt; tile_map(t, T, 8, mt, nt);
          f32x4 acc[4][4]; zero_acc(acc);
          gemm_core<true, true>((const u16*)(ws + W_U), 4096, (const u16*)(ws + W_W2), 4096, mt * 128, nt * 128, smem, acc);
          const WavePos w = wave_pos(mt * 128, nt * 128);
          store_all((u16*)(ws + W_T), 1024, w.nb, w, acc);
        }
      } else {
        if (l + 1 < DEPTH)
          for (int it = blockIdx.x; it < CONV_ITEMS; it += gridDim.x) convert_item(P, l + 1, it, smem);
        rows_phase(P, 2, l);
      }
#if PROBE_SUB >= 0
      }
#endif
    }
#if MK_COOP
    if (ph + 1 < ph_hi) {
      if (ph_hi < 0) cg::this_grid().sync();
      xcd_barrier(bar, xb_x, xb_nloc, xb_nx);
    }
#endif
  }
}

extern "C" void kernel_launch(void* const* d_in, const int* in_sizes, int n_in, void* d_out, int out_size, void* d_ws, size_t ws_size,
                              hipStream_t stream) {
  static int grid = 0;
  if (grid == 0) {
    int dev = 0, cus = 0, per_cu = 0;
    hipGetDevice(&dev);
    hipDeviceGetAttribute(&cus, hipDeviceAttributeMultiprocessorCount, dev);
    hipFuncSetAttribute((const void*)fwd_kernel, hipFuncAttributeMaxDynamicSharedMemorySize, LDS_BYTES);
    hipOccupancyMaxActiveBlocksPerMultiprocessor(&per_cu, (const void*)fwd_kernel, 256, LDS_BYTES);
    if (per_cu < 1) per_cu = 1;
    if (per_cu > 2) per_cu = 2;
    grid = cus * per_cu;
    if (n_in != 30 || ws_size < W_END) { fprintf(stderr, "kernel_launch: unexpected n_in %d / ws_size %zu (need %zu)\n", n_in, ws_size, (size_t)W_END); }
  }
  Params p{};
  for (int i = 0; i < 30; ++i) p.in[i] = (const float*)d_in[i];
  p.out = (float*)d_out;
  p.ws = (unsigned char*)d_ws;
#if MK_COOP
  hipMemsetAsync((unsigned char*)d_ws + W_BAR, 0, XCD_BAR_WORDS * 4, stream);
  int lo = 0, hi = NPHASE;
  void* args[] = {&p, &lo, &hi};
  hipError_t e = hipLaunchCooperativeKernel((const void*)fwd_kernel, dim3(grid), dim3(256), args, LDS_BYTES, stream);
  if (e != hipSuccess) fprintf(stderr, "cooperative launch failed: %s (grid %d)\n", hipGetErrorString(e), grid);
#else
  for (int ph = 0; ph < NPHASE; ++ph) hipLaunchKernelGGL(fwd_kernel, dim3(grid), dim3(256), LDS_BYTES, stream, p, ph, ph + 1);
#endif
}
```
